# Optimizing an MI355X kernel written in HIP

```python
import jax
import jax.numpy as jnp
from jax import lax
import numpy as np

D_MODEL = 1024
BATCH = 2
SEQ = 8192
DEPTH = 2

GRID_W = 64
CTX_LEN = 256
N_MIXERS = 2
EXPAND = 2
D_INNER = EXPAND * D_MODEL
MLSTM_HEADS = 4
MLSTM_HEAD_DIM = D_INNER // MLSTM_HEADS
QKV_BLOCK = 4
CONV_W = 3
CHUNK = 64
POOL_WINDOWS = (2, 4, 8, 16)
POOL_GROUPS = len(POOL_WINDOWS)
POOL_GROUP_DIM = D_INNER // POOL_GROUPS
N_LAYERS_A = (DEPTH + 1) // 2
N_LAYERS_B = DEPTH // 2
EPS = 1e-6

kernel_name = "hybrid_mlstm_pool_diffusion_block"


def rmsnorm(x, g):
    xf = x.astype(jnp.float32)
    y = xf * lax.rsqrt(jnp.mean(xf * xf, axis=-1, keepdims=True) + EPS)
    return (y * g.astype(jnp.float32)).astype(x.dtype)


def ada(cond, w, b):
    mod = jax.nn.silu(cond) @ w + b
    return jnp.split(mod, 3, axis=-1)


def modulate(h, shift, scale):
    return h * (1.0 + scale) + shift


def short_conv(x, w, b):
    pad = CONV_W // 2
    t = x.shape[1]
    xp = jnp.pad(x, ((0, 0), (pad, CONV_W - 1 - pad), (0, 0)))
    y = xp[:, 0:t] * w[0]
    for j in range(1, CONV_W):
        y = y + xp[:, j:j + t] * w[j]
    return y + b


def headwise(x, w):
    bsz, t, e = x.shape
    xb = x.reshape(bsz, t, e // QKV_BLOCK, QKV_BLOCK)
    return jnp.einsum("btgi,gio->btgo", xb, w).reshape(bsz, t, e)


def to_heads(x):
    bsz, t, _ = x.shape
    return x.reshape(bsz, t, MLSTM_HEADS, MLSTM_HEAD_DIM).transpose(0, 2, 1, 3).astype(jnp.float32)


def to_chunks(a):
    bsz, h, t = a.shape[:3]
    a = a.reshape(bsz, h, t // CHUNK, CHUNK, *a.shape[3:])
    return jnp.moveaxis(a, 2, 0)


def mlstm_scan(q, k, v, log_i, log_f, state):
    tril = jnp.tril(jnp.ones((CHUNK, CHUNK), dtype=bool))

    def step(carry, chunk):
        c_mem, n_vec, m_prev = carry
        qc, kc, vc, ic, fc = chunk
        b = jnp.cumsum(fc, axis=-1)
        d = jnp.where(tril, b[..., :, None] - b[..., None, :] + ic[..., None, :], -jnp.inf)
        m_inter = b + m_prev[..., None]
        m_t = jnp.maximum(m_inter, jnp.max(d, axis=-1))
        s = jnp.einsum("bhld,bhsd->bhls", qc, kc) * jnp.exp(d - m_t[..., None])
        w_inter = jnp.exp(m_inter - m_t)
        num = jnp.einsum("bhls,bhse->bhle", s, vc) + w_inter[..., None] * jnp.einsum("bhld,bhde->bhle", qc, c_mem)
        den = jnp.sum(s, axis=-1) + w_inter * jnp.einsum("bhld,bhd->bhl", qc, n_vec)
        h = num / jnp.maximum(jnp.abs(den), jnp.exp(-m_t))[..., None]
        b_last = b[..., -1]
        g = b_last[..., None] - b + ic
        m_new = jnp.maximum(b_last + m_prev, jnp.max(g, axis=-1))
        decay = jnp.exp(b_last + m_prev - m_new)
        wk = kc * jnp.exp(g - m_new[..., None])[..., None]
        c_new = decay[..., None, None] * c_mem + jnp.einsum("bhsd,bhse->bhde", wk, vc)
        n_new = decay[..., None] * n_vec + jnp.sum(wk, axis=2)
        return (c_new, n_new, m_new), h

    xs = (to_chunks(q), to_chunks(k), to_chunks(v), to_chunks(log_i), to_chunks(log_f))
    state, h = lax.scan(step, state, xs)
    h = jnp.moveaxis(h, 0, 2)
    bsz, nh, nc, l, dh = h.shape
    return h.reshape(bsz, nh, nc * l, dh), state


def mlstm_features(h, w_in, conv_w, conv_b, w_q, w_k, w_v):
    xm, z, og = jnp.split(h @ w_in, 3, axis=-1)
    xc = jax.nn.silu(short_conv(xm, conv_w, conv_b))
    q = headwise(xc, w_q)
    k = headwise(xc, w_k) * (MLSTM_HEAD_DIM ** -0.5)
    v = headwise(xm, w_v)
    return q, k, v, xc, z, og


def gate_logs(qkv, w_g, b_g):
    pre = (qkv @ w_g + b_g).astype(jnp.float32)
    log_i = pre[..., :MLSTM_HEADS]
    log_f = jax.nn.log_sigmoid(pre[..., MLSTM_HEADS:])
    return log_i.transpose(0, 2, 1), log_f.transpose(0, 2, 1)


def bidir_mlstm(q, k, v, w_gf, b_gf, w_gb, b_gb, init_f, init_b):
    qkv = jnp.concatenate([q, k, v], axis=-1)
    li_f, lf_f = gate_logs(qkv, w_gf, b_gf)
    li_b, lf_b = gate_logs(qkv, w_gb, b_gb)
    qh, kh, vh = to_heads(q), to_heads(k), to_heads(v)
    h_f, st_f = mlstm_scan(qh, kh, vh, li_f, lf_f, init_f)
    flip = lambda a: jnp.flip(a, axis=2)
    h_b, st_b = mlstm_scan(flip(qh), flip(kh), flip(vh), jnp.flip(li_b, -1), jnp.flip(lf_b, -1), init_b)
    return h_f + flip(h_b), st_f, st_b


def mlstm_output(hsum, xc, z, og, head_norm, skip, w_out):
    hs = hsum.transpose(0, 2, 1, 3)
    mu = jnp.mean(hs, axis=-1, keepdims=True)
    var = jnp.mean(jnp.square(hs - mu), axis=-1, keepdims=True)
    hn = ((hs - mu) * lax.rsqrt(var + EPS)).reshape(hs.shape[0], hs.shape[1], D_INNER).astype(xc.dtype) * head_norm
    y = jax.nn.sigmoid(og) * hn + skip * xc
    return (y * jax.nn.silu(z)) @ w_out


def mlstm_mixer(h_lat, h_ctx, ctx_out, w_in, conv_w, conv_b, w_q, w_k, w_v,
                w_gf, b_gf, w_gb, b_gb, head_norm, skip, w_out):
    bsz = h_lat.shape[0]
    zero = (jnp.zeros((bsz, MLSTM_HEADS, MLSTM_HEAD_DIM, MLSTM_HEAD_DIM), jnp.float32),
            jnp.zeros((bsz, MLSTM_HEADS, MLSTM_HEAD_DIM), jnp.float32),
            jnp.zeros((bsz, MLSTM_HEADS), jnp.float32))
    qc, kc, vc, xcc, zc, ogc = mlstm_features(h_ctx, w_in, conv_w, conv_b, w_q, w_k, w_v)
    h_c, st_f, st_b = bidir_mlstm(qc, kc, vc, w_gf, b_gf, w_gb, b_gb, zero, zero)
    ql, kl, vl, xcl, zl, ogl = mlstm_features(h_lat, w_in, conv_w, conv_b, w_q, w_k, w_v)
    h_l, _, _ = bidir_mlstm(ql, kl, vl, w_gf, b_gf, w_gb, b_gb, st_f, st_b)
    y_lat = mlstm_output(h_l, xcl, zl, ogl, head_norm, skip, w_out)
    y_ctx = mlstm_output(h_c, xcc, zc, ogc, head_norm, skip, w_out) if ctx_out else None
    return y_lat, y_ctx


def box_mean(x, w, axis):
    n = x.shape[axis]
    pad = [(0, 0)] * x.ndim
    pad[axis] = (1, 0)
    cs = jnp.pad(jnp.cumsum(x, axis=axis), pad)
    idx = np.arange(n)
    lo = np.clip(idx - w // 2, 0, n)
    hi = np.clip(idx + w - w // 2, 0, n)
    s = jnp.take(cs, hi, axis=axis) - jnp.take(cs, lo, axis=axis)
    shape = [1] * x.ndim
    shape[axis] = n
    cnt = (hi - lo).astype(np.float32).reshape(shape)
    return s / cnt


def pool_mixer(h, grid, w_in, w_pool, pool_scale, w_out):
    u, z = jnp.split(h @ w_in, 2, axis=-1)
    bsz, t, _ = u.shape
    ug = u.reshape(bsz, t, POOL_GROUPS, POOL_GROUP_DIM).astype(jnp.float32)
    diffs = []
    for g, w in enumerate(POOL_WINDOWS):
        xg = ug[:, :, g, :]
        if grid:
            rows = t // GRID_W
            x2 = xg.reshape(bsz, rows, GRID_W, POOL_GROUP_DIM)
            m = box_mean(box_mean(x2, w, 2), w, 1).reshape(bsz, t, POOL_GROUP_DIM)
        else:
            m = box_mean(xg, w, 1)
        diffs.append(m - xg)
    d = jnp.stack(diffs, axis=2).astype(h.dtype)
    y = jnp.einsum("btgi,gio->btgo", d, w_pool).reshape(bsz, t, D_INNER) * pool_scale
    return (y * jax.nn.silu(z)) @ w_out


def setup_inputs(seed: int = 0) -> dict:
    key = jax.random.key(seed)
    ks = jax.random.split(key, 32)
    nrm = lambda k, shape, s: jax.random.normal(k, shape, jnp.float32) * s
    d, e, h = D_MODEL, D_INNER, MLSTM_HEADS
    na, nb = N_LAYERS_A, N_LAYERS_B
    b_gate = lambda k: jnp.concatenate([
        nrm(k, (na, h), 0.1),
        jnp.broadcast_to(jnp.linspace(3.0, 6.0, h, dtype=jnp.float32), (na, h)) + nrm(jax.random.fold_in(k, 1), (na, h), 0.1)], axis=-1)
    return {
        "x": nrm(ks[0], (BATCH, SEQ, d), 1.0),
        "c": nrm(ks[1], (BATCH, d), 1.0),
        "ctx": nrm(ks[2], (BATCH, CTX_LEN, d), 1.0),
        "c_ctx": nrm(ks[3], (d,), 1.0),
        "w_ada": nrm(ks[4], (DEPTH, d, 3 * d), d ** -0.5),
        "b_ada": nrm(ks[5], (DEPTH, 3 * d), 0.02),
        "a_norm_pre": 1.0 + nrm(ks[6], (na, d), 0.02),
        "a_norm_post": 1.0 + nrm(ks[7], (na, d), 0.02),
        "a_w_in": nrm(ks[8], (na, d, 3 * e), d ** -0.5),
        "a_conv_w": nrm(ks[9], (na, CONV_W, e), CONV_W ** -0.5),
        "a_conv_b": nrm(ks[10], (na, e), 0.02),
        "a_w_q": nrm(ks[11], (na, e // QKV_BLOCK, QKV_BLOCK, QKV_BLOCK), QKV_BLOCK ** -0.5),
        "a_w_k": nrm(ks[12], (na, e // QKV_BLOCK, QKV_BLOCK, QKV_BLOCK), QKV_BLOCK ** -0.5),
        "a_w_v": nrm(ks[13], (na, e // QKV_BLOCK, QKV_BLOCK, QKV_BLOCK), QKV_BLOCK ** -0.5),
        "a_w_gate_f": nrm(ks[14], (na, 3 * e, 2 * h), 0.5 * (3 * e) ** -0.5),
        "a_b_gate_f": b_gate(ks[15]),
        "a_w_gate_b": nrm(ks[16], (na, 3 * e, 2 * h), 0.5 * (3 * e) ** -0.5),
        "a_b_gate_b": b_gate(ks[17]),
        "a_head_norm": 1.0 + nrm(ks[18], (na, e), 0.02),
        "a_skip": 1.0 + nrm(ks[19], (na, e), 0.02),
        "a_w_out": nrm(ks[20], (na, e, d), e ** -0.5),
        "b_norm_pre": 1.0 + nrm(ks[21], (nb, d), 0.02),
        "b_norm_post": 1.0 + nrm(ks[22], (nb, d), 0.02),
        "b_w_in": nrm(ks[23], (nb, d, 2 * e), d ** -0.5),
        "b_w_pool": nrm(ks[24], (nb, POOL_GROUPS, POOL_GROUP_DIM, POOL_GROUP_DIM), POOL_GROUP_DIM ** -0.5),
        "b_pool_scale": 1.0 + nrm(ks[25], (nb, e), 0.1),
        "b_w_out": nrm(ks[26], (nb, e, d), e ** -0.5),
    }


def reference(x, c, ctx, c_ctx, w_ada, b_ada,
              a_norm_pre, a_norm_post, a_w_in, a_conv_w, a_conv_b, a_w_q, a_w_k, a_w_v,
              a_w_gate_f, a_b_gate_f, a_w_gate_b, a_b_gate_b, a_head_norm, a_skip, a_w_out,
              b_norm_pre, b_norm_post, b_w_in, b_w_pool, b_pool_scale, b_w_out):
    for i in range(DEPTH):
        kind = i % N_MIXERS
        j = i // N_MIXERS
        ctx_out = any(l % N_MIXERS == 0 for l in range(i + 1, DEPTH))
        ctx_in = (kind == 0) or ctx_out
        shift, scale, gate = ada(c, w_ada[i], b_ada[i])
        pre_g = a_norm_pre[j] if kind == 0 else b_norm_pre[j]
        post_g = a_norm_post[j] if kind == 0 else b_norm_post[j]
        h_lat = modulate(rmsnorm(x, pre_g), shift[:, None, :], scale[:, None, :])
        if ctx_in:
            c_shift, c_scale, c_gate = ada(c_ctx, w_ada[i], b_ada[i])
            h_ctx = modulate(rmsnorm(ctx, pre_g), c_shift, c_scale)
        if kind == 0:
            y_lat, y_ctx = mlstm_mixer(h_lat, h_ctx, ctx_out, a_w_in[j], a_conv_w[j], a_conv_b[j],
                                       a_w_q[j], a_w_k[j], a_w_v[j], a_w_gate_f[j], a_b_gate_f[j],
                                       a_w_gate_b[j], a_b_gate_b[j], a_head_norm[j], a_skip[j], a_w_out[j])
        else:
            y_lat = pool_mixer(h_lat, True, b_w_in[j], b_w_pool[j], b_pool_scale[j], b_w_out[j])
            y_ctx = pool_mixer(h_ctx, False, b_w_in[j], b_w_pool[j], b_pool_scale[j], b_w_out[j]) if ctx_out else None
        x = x + gate[:, None, :] * rmsnorm(y_lat, post_g)
        if ctx_out:
            ctx = ctx + c_gate * rmsnorm(y_ctx, post_g)
    return x
```

```cpp
#include <hip/hip_runtime.h>
#include <hip/hip_cooperative_groups.h>
#include <cstdio>
#include <cstdint>
namespace cg = cooperative_groups;

#define DI __device__ __forceinline__
#define LAS __attribute__((address_space(3)))
typedef unsigned short bf16;
typedef unsigned v4u __attribute__((ext_vector_type(4)));
typedef unsigned v2u __attribute__((ext_vector_type(2)));
typedef float f32x4 __attribute__((ext_vector_type(4)));
typedef float f32x2 __attribute__((ext_vector_type(2)));
typedef float f32x16 __attribute__((ext_vector_type(16)));
typedef short bf16x8 __attribute__((ext_vector_type(8)));
typedef __bf16 bf16x2_t __attribute__((ext_vector_type(2)));

constexpr int NB = 2, T = 8192, DM = 1024, E = 2048, NH = 4, DH = 512, TC = 256;
constexpr int M_LAT = NB * T, M_CTX = NB * TC, M_ALL = M_LAT + M_CTX;
constexpr int NCC = 264;
constexpr int NWAVES = 8, NTHR = 512;
constexpr float EPS = 1e-6f;

constexpr size_t MiB = 1u << 20, KiB = 1u << 10;
constexpr size_t WS_MOD = 128 * KiB;
constexpr size_t WS_GT = 256 * KiB;
constexpr size_t WS_MQ = 384 * KiB;
constexpr size_t WS_GC = 448 * KiB;
constexpr size_t WS_WXM = 2 * MiB, WS_WZO = 6 * MiB, WS_WOA = 14 * MiB;
constexpr size_t WS_XMC = 18 * MiB;
constexpr size_t WS_QA = 20 * MiB;
constexpr size_t WS_KA = 86 * MiB;
constexpr size_t WS_QK = 152 * MiB;
constexpr size_t WS_GP = 161 * MiB;
constexpr size_t WS_GS = 166 * MiB;
constexpr size_t WS_ST = 169 * MiB;
constexpr size_t WS_H = 170 * MiB;
constexpr size_t WS_HN = 170 * MiB;
constexpr size_t WS_WBIN = 234 * MiB, WS_WPOOL = 242 * MiB, WS_WBOUT = 244 * MiB;
constexpr size_t WS_HN2 = 20 * MiB;
constexpr size_t WS_Y = 86 * MiB;
constexpr size_t WS_YL = 20 * MiB;
constexpr size_t WS_HN1 = 152 * MiB;
constexpr size_t WS_U = 20 * MiB;
constexpr size_t WS_Z1 = 86 * MiB;
constexpr size_t WS_M1 = 152 * MiB;
constexpr size_t WS_Y1 = 152 * MiB;
constexpr size_t WS_YL1 = 20 * MiB;
constexpr size_t WS_END = 256 * MiB;

DI unsigned pk2(float lo, float hi) { f32x2 v = {lo, hi}; bf16x2_t b = __builtin_convertvector(v, bf16x2_t); return __builtin_bit_cast(unsigned, b); }
DI float bflo(unsigned u) { return __uint_as_float(u << 16); }
DI float bfhi(unsigned u) { return __uint_as_float(u & 0xffff0000u); }
DI float sigmoidf_(float x) { return __builtin_amdgcn_rcpf(1.f + __expf(-x)); }
DI float siluf_(float x) { return x * sigmoidf_(x); }
DI float wave_sum(float v) {
#pragma unroll
    for (int o = 1; o < 64; o <<= 1) v += __shfl_xor(v, o);
    return v;
}
namespace pg8 {
#define PG8_LAS __attribute__((address_space(3)))
typedef unsigned short bf16_t;
typedef short bf16x8 __attribute__((ext_vector_type(8)));
typedef float f32x4 __attribute__((ext_vector_type(4)));
typedef unsigned u32x4 __attribute__((ext_vector_type(4)));
constexpr int BM = 256, BK = 64, HALF = 128, HTB = HALF * BK * 2  , STAGE_BYTES = 8 * HTB, NXCD = 8, WGM = 8;

__host__ __device__ __forceinline__ int lds_byte(int r, int c) { const int st = (r >> 4) * 2 + (c >> 5), rr = r & 15, cc = c & 31, ob = rr * 64 + cc * 2; return st * 1024 + (ob ^ (((ob >> 9) & 1) << 5)); }
__host__ __device__ __forceinline__ void stage_rc(int b, int& R, int& C) { const int st = b / 1024, sb = b % 1024, swz = sb ^ (((sb >> 9) & 1) << 5); R = (st >> 1) * 16 + swz / 64; C = (st & 1) * 32 + (swz % 64) / 2; }
__host__ __device__ __forceinline__ int perm32(int rho) { const int n = rho >> 4, i = rho & 15; return 8 * (i >> 2) + 4 * n + (i & 3); }

struct Unit { int pm, pn; };
struct Gemm { const bf16_t* A; const bf16_t* Bt; int M, N, K, lda, ldb, agrp_shift;
    __device__ __forceinline__ size_t akoff(int pn) const { return agrp_shift >= 0 ? (size_t)(pn >> agrp_shift) * (size_t)K * 2 : (size_t)0; } };
struct StaticOrder {
    int nM, nN, nwg, G, c;
    __host__ __device__ void init(int M, int N, int G_, int c_) { nM = M / BM; nN = N / BM; nwg = nM * nN; G = G_; c = c_; }
    __host__ __device__ bool next(int i, Unit& u) const {
        const long L = (long)i * G + c; if (L >= nwg) return false;
        int wgid = (int)L; { const int q = nwg / NXCD, r = nwg % NXCD, xcd = wgid % NXCD, off = wgid / NXCD; wgid = (xcd < r ? xcd * (q + 1) : r * (q + 1) + (xcd - r) * q) + off; }
        const int nig = WGM * nN, gid = wgid / nig, fm = gid * WGM, gsz = (nM - fm) < WGM ? (nM - fm) : WGM;
        u.pm = fm + ((wgid % nig) % gsz); u.pn = (wgid % nig) / gsz; return true;
    }
    __device__ __forceinline__ void a_ready(const Unit&) const {}
    __device__ __forceinline__ void done(const Unit&) const {}
};
__device__ __forceinline__ unsigned pk2e(float lo, float hi) { return ::pk2(lo, hi); }
__device__ __forceinline__ float silu_e(float x) { return x * __builtin_amdgcn_rcpf(1.f + __expf(-x)); }
__device__ __forceinline__ float sigm_e(float x) { return __builtin_amdgcn_rcpf(1.f + __expf(-x)); }

struct EpiXM {
    static constexpr bool PERM = true, AFTER_DRAIN = false;
    bf16_t* Olat; bf16_t* Octx;
    __device__ __forceinline__ void operator()(const f32x4 (&acc)[2][2][4][2], const Unit& u, int wr, int wc, int fr, int fq) const {
        const int row0 = u.pm * BM + wr * 64 + fr, col0 = u.pn * BM + wc * 32 + 8 * fq;
        bf16_t* base = (u.pm < 64) ? Olat : Octx - (size_t)16384 * 2048;
#pragma unroll
        for (int ai = 0; ai < 2; ++ai)
#pragma unroll
            for (int m = 0; m < 4; ++m) { bf16_t* rowp = base + (size_t)(row0 + ai * HALF + m * 16) * 2048 + col0;
#pragma unroll
                for (int bj = 0; bj < 2; ++bj) { const f32x4 v0 = acc[ai][bj][m][0], v1 = acc[ai][bj][m][1];
                    u32x4 w; w.x = pk2e(v0[0], v0[1]); w.y = pk2e(v0[2], v0[3]); w.z = pk2e(v1[0], v1[1]); w.w = pk2e(v1[2], v1[3]);
                    *(u32x4*)(rowp + bj * HALF) = w; } }
    }
};
struct EpiUZ {
    static constexpr bool PERM = true, AFTER_DRAIN = false;
    bf16_t* U; bf16_t* Z1;
    __device__ __forceinline__ void operator()(const f32x4 (&acc)[2][2][4][2], const Unit& u, int wr, int wc, int fr, int fq) const {
        const int row0 = u.pm * BM + wr * 64 + fr; int colt = u.pn * BM; const bool isz = colt >= 2048; bf16_t* base = isz ? Z1 : U; if (isz) colt -= 2048;
        const int col0 = colt + wc * 32 + 8 * fq;
#pragma unroll
        for (int ai = 0; ai < 2; ++ai)
#pragma unroll
            for (int m = 0; m < 4; ++m) { bf16_t* rowp = base + (size_t)(row0 + ai * HALF + m * 16) * 2048 + col0;
#pragma unroll
                for (int bj = 0; bj < 2; ++bj) { f32x4 v0 = acc[ai][bj][m][0], v1 = acc[ai][bj][m][1];
                    if (isz) {
#pragma unroll
                        for (int e = 0; e < 4; ++e) { v0[e] = silu_e(v0[e]); v1[e] = silu_e(v1[e]); } }
                    u32x4 w; w.x = pk2e(v0[0], v0[1]); w.y = pk2e(v0[2], v0[3]); w.z = pk2e(v1[0], v1[1]); w.w = pk2e(v1[2], v1[3]);
                    *(u32x4*)(rowp + bj * HALF) = w; } }
    }
};
struct EpiF32 {
    static constexpr bool PERM = false, AFTER_DRAIN = false;
    float* O; int ldc;
    __device__ __forceinline__ void operator()(const f32x4 (&acc)[2][2][4][2], const Unit& u, int wr, int wc, int fr, int fq) const {
        const int row0 = u.pm * BM + wr * 64 + fr, col0 = u.pn * BM + wc * 32 + 4 * fq;
#pragma unroll
        for (int ai = 0; ai < 2; ++ai)
#pragma unroll
            for (int m = 0; m < 4; ++m) { float* rowp = O + (size_t)(row0 + ai * HALF + m * 16) * ldc + col0;
#pragma unroll
                for (int bj = 0; bj < 2; ++bj)
#pragma unroll
                    for (int n = 0; n < 2; ++n) *(f32x4*)(rowp + bj * HALF + n * 16) = acc[ai][bj][m][n]; }
    }
};
struct EpiPool {
    static constexpr bool PERM = true, AFTER_DRAIN = false;
    bf16_t* O; const bf16_t* Z1; const float* ps;
    __device__ __forceinline__ void operator()(const f32x4 (&acc)[2][2][4][2], const Unit& u, int wr, int wc, int fr, int fq) const {
        const int row0 = u.pm * BM + wr * 64 + fr, col0 = u.pn * BM + wc * 32 + 8 * fq;
        f32x4 sv[2][2];
#pragma unroll
        for (int bj = 0; bj < 2; ++bj)
#pragma unroll
            for (int n = 0; n < 2; ++n) sv[bj][n] = *(const f32x4*)(ps + col0 + bj * HALF + 4 * n);
#pragma unroll
        for (int ai = 0; ai < 2; ++ai)
#pragma unroll
            for (int m = 0; m < 4; ++m) { const size_t off = (size_t)(row0 + ai * HALF + m * 16) * 2048 + col0;
#pragma unroll
                for (int bj = 0; bj < 2; ++bj) { const u32x4 zz = *(const u32x4*)(Z1 + off + bj * HALF);
                    const f32x4 v0 = acc[ai][bj][m][0] * sv[bj][0], v1 = acc[ai][bj][m][1] * sv[bj][1];
                    u32x4 w; w.x = pk2e(v0[0] * ::bflo(zz.x), v0[1] * ::bfhi(zz.x)); w.y = pk2e(v0[2] * ::bflo(zz.y), v0[3] * ::bfhi(zz.y));
                    w.z = pk2e(v1[0] * ::bflo(zz.z), v1[1] * ::bfhi(zz.z)); w.w = pk2e(v1[2] * ::bflo(zz.w), v1[3] * ::bfhi(zz.w));
                    *(u32x4*)(O + off + bj * HALF) = w; } }
    }
};
struct EpiMix {
    static constexpr bool PERM = true, AFTER_DRAIN = false;
    bf16_t* Y; const bf16_t* Hs; const bf16_t* XM; const float* stats; const float* convw; const float* convb; const float* headn; const float* skip;
    __device__ __forceinline__ void operator()(const f32x4 (&acc)[2][2][4][2], const Unit& u, int wr, int wc, int fr, int fq) const {
        const int row0 = u.pm * BM + wr * 64 + fr, f0 = u.pn * HALF + wc * 32 + 8 * fq, head = f0 >> 9;
        float c0[8], c1[8], c2[8], cb[8], hw[8], sk[8];
#pragma unroll
        for (int q = 0; q < 2; ++q) { const f32x4 a = *(const f32x4*)(convw + f0 + 4 * q), b = *(const f32x4*)(convw + 2048 + f0 + 4 * q), c = *(const f32x4*)(convw + 4096 + f0 + 4 * q),
                d = *(const f32x4*)(convb + f0 + 4 * q), e = *(const f32x4*)(headn + f0 + 4 * q), f = *(const f32x4*)(skip + f0 + 4 * q);
#pragma unroll
            for (int i = 0; i < 4; ++i) { c0[4 * q + i] = a[i]; c1[4 * q + i] = b[i]; c2[4 * q + i] = c[i]; cb[4 * q + i] = d[i]; hw[4 * q + i] = e[i]; sk[4 * q + i] = f[i]; } }
#pragma unroll
        for (int ai = 0; ai < 2; ++ai)
#pragma unroll
            for (int m = 0; m < 4; ++m) {
                const int row = row0 + ai * HALF + m * 16, t = row & 8191; const size_t off = (size_t)row * 2048 + f0;
                const u32x4 hv = *(const u32x4*)(Hs + off), x1 = *(const u32x4*)(XM + off);
                u32x4 x0 = (u32x4){0u, 0u, 0u, 0u}, x2 = (u32x4){0u, 0u, 0u, 0u};
                if (t > 0) x0 = *(const u32x4*)(XM + off - 2048);
                if (t < 8191) x2 = *(const u32x4*)(XM + off + 2048);
                const float mean = stats[(size_t)row * 8 + head * 2], rstd = stats[(size_t)row * 8 + head * 2 + 1];
                float hh[8], a0[8], a1[8], a2[8];
                hh[0] = ::bflo(hv.x); hh[1] = ::bfhi(hv.x); hh[2] = ::bflo(hv.y); hh[3] = ::bfhi(hv.y); hh[4] = ::bflo(hv.z); hh[5] = ::bfhi(hv.z); hh[6] = ::bflo(hv.w); hh[7] = ::bfhi(hv.w);
                a0[0] = ::bflo(x0.x); a0[1] = ::bfhi(x0.x); a0[2] = ::bflo(x0.y); a0[3] = ::bfhi(x0.y); a0[4] = ::bflo(x0.z); a0[5] = ::bfhi(x0.z); a0[6] = ::bflo(x0.w); a0[7] = ::bfhi(x0.w);
                a1[0] = ::bflo(x1.x); a1[1] = ::bfhi(x1.x); a1[2] = ::bflo(x1.y); a1[3] = ::bfhi(x1.y); a1[4] = ::bflo(x1.z); a1[5] = ::bfhi(x1.z); a1[6] = ::bflo(x1.w); a1[7] = ::bfhi(x1.w);
                a2[0] = ::bflo(x2.x); a2[1] = ::bfhi(x2.x); a2[2] = ::bflo(x2.y); a2[3] = ::bfhi(x2.y); a2[4] = ::bflo(x2.z); a2[5] = ::bfhi(x2.z); a2[6] = ::bflo(x2.w); a2[7] = ::bfhi(x2.w);
                float y[8];
#pragma unroll
                for (int e = 0; e < 8; ++e) {
                    const float z = acc[ai][0][m][e >> 2][e & 3], og = acc[ai][1][m][e >> 2][e & 3];
                    const float cv = c0[e] * a0[e] + c1[e] * a1[e] + c2[e] * a2[e] + cb[e];
                    const float xc = silu_e(cv), hn = (hh[e] - mean) * rstd * hw[e];
                    y[e] = (sigm_e(og) * hn + sk[e] * xc) * silu_e(z);
                }
                u32x4 w; w.x = pk2e(y[0], y[1]); w.y = pk2e(y[2], y[3]); w.z = pk2e(y[4], y[5]); w.w = pk2e(y[6], y[7]);
                *(u32x4*)(Y + off) = w;
            }
    }
};

template <class Epi, class Sched, bool ALIGN_EPI = false, bool SP2 = false>
__device__ __forceinline__ void gemm_phase(PG8_LAS unsigned char* lds, const Gemm g, const Sched& S, const Epi& E) {
    const int tid = threadIdx.x, wid = __builtin_amdgcn_readfirstlane(tid >> 6), lane = tid & 63, wr = wid >> 2, wc = wid & 3, fr = lane & 15, fq = lane >> 4;
    const int K = g.K, nt = K / BK;
    unsigned voffA[2], voffB[2];
#pragma unroll
    for (int i = 0; i < 2; ++i) { int R, C; stage_rc(tid * 16 + i * 8192, R, C); const int Rb = Epi::PERM ? ((R & ~31) + perm32(R & 31)) : R;
        voffA[i] = (unsigned)(R * g.lda + C) * 2u; voffB[i] = (unsigned)(Rb * g.ldb + C) * 2u; }
    const size_t kstep = (size_t)(BK * 2);
    const size_t hstepA = (size_t)HALF * g.lda * 2, hstepB = (size_t)HALF * g.ldb * 2;
    const size_t tstepA = 2 * hstepA, tstepB = 2 * hstepB;
    const unsigned ldsw = (unsigned)wid * 1024u;
    const int aoff = lds_byte(wr * 64 + fr, fq * 8), boff = lds_byte(wc * 32 + fr, fq * 8);
#define PG8_SA(b, h) (((b) * 2 + (h)) * HTB)
#define PG8_SB(b, h) ((4 + (b) * 2 + (h)) * HTB)
#define PG8_STAGE(bufoff, gbase, voff) do { _Pragma("unroll") for (int _i = 0; _i < 2; ++_i) \
        __builtin_amdgcn_global_load_lds((const unsigned*)((const char*)(gbase) + (voff)[_i]), (PG8_LAS unsigned*)(lds + (bufoff) + ldsw + _i * 8192), 16, 0, 0); } while (0)
#define PG8_LDA(dst, b, h) do { _Pragma("unroll") for (int m = 0; m < 4; ++m) _Pragma("unroll") for (int k = 0; k < 2; ++k) dst[m][k] = *(const PG8_LAS bf16x8*)(lds + PG8_SA(b, h) + aoff + m * 2048 + k * 1024); } while (0)
#define PG8_LDB(dst, b, h) do { _Pragma("unroll") for (int n = 0; n < 2; ++n) _Pragma("unroll") for (int k = 0; k < 2; ++k) dst[n][k] = *(const PG8_LAS bf16x8*)(lds + PG8_SB(b, h) + boff + n * 2048 + k * 1024); } while (0)
#define PG8_MMA(ai, bj, At, Bt) do { __builtin_amdgcn_s_setprio(1); _Pragma("unroll") for (int m = 0; m < 4; ++m) _Pragma("unroll") for (int n = 0; n < 2; ++n) _Pragma("unroll") for (int k = 0; k < 2; ++k) \
        acc[ai][bj][m][n] = __builtin_amdgcn_mfma_f32_16x16x32_bf16(Bt[n][k], At[m][k], acc[ai][bj][m][n], 0, 0, 0); __builtin_amdgcn_s_setprio(0); } while (0)
#define PG8_WAIT_V(n) asm volatile("s_waitcnt vmcnt(" #n ")" ::: "memory")
#define PG8_WAIT_L(n) asm volatile("s_waitcnt lgkmcnt(" #n ")" ::: "memory")
#define PG8_BAR __builtin_amdgcn_s_barrier()
#define PG8_SCHED __builtin_amdgcn_sched_barrier(0)
    Unit cur, nxt; int ui = 0;
    if (!S.next(0, cur)) return;
    f32x4 acc[2][2][4][2];
#pragma unroll
    for (int a = 0; a < 2; ++a)
#pragma unroll
        for (int b = 0; b < 2; ++b)
#pragma unroll
            for (int m = 0; m < 4; ++m)
#pragma unroll
                for (int n = 0; n < 2; ++n) acc[a][b][m][n] = (f32x4){0.f, 0.f, 0.f, 0.f};
    bf16x8 At[4][2], B0[2][2], B1[2][2];
    const char* cA = (const char*)g.A + (size_t)cur.pm * tstepA + g.akoff(cur.pn); const char* cB = (const char*)g.Bt + (size_t)cur.pn * tstepB;
    S.a_ready(cur);
    if constexpr (SP2) {
        PG8_STAGE(PG8_SB(0, 0), cB, voffB); PG8_STAGE(PG8_SB(0, 1), cB + hstepB, voffB); PG8_STAGE(PG8_SA(0, 0), cA, voffA); PG8_STAGE(PG8_SA(0, 1), cA + hstepA, voffA);
        if (wr == 1) PG8_BAR;
        PG8_WAIT_V(2); PG8_BAR;
        PG8_STAGE(PG8_SB(1, 0), cB + kstep, voffB); PG8_STAGE(PG8_SA(1, 0), cA + kstep, voffA); PG8_STAGE(PG8_SB(1, 1), cB + hstepB + kstep, voffB);
        PG8_WAIT_V(6); PG8_BAR;
    } else {
        PG8_STAGE(PG8_SB(0, 0), cB, voffB); PG8_STAGE(PG8_SA(0, 0), cA, voffA); PG8_STAGE(PG8_SB(0, 1), cB + hstepB, voffB); PG8_STAGE(PG8_SA(0, 1), cA + hstepA, voffA);
        if (wr == 1) PG8_BAR;
        PG8_WAIT_V(4); PG8_BAR;
        PG8_STAGE(PG8_SB(1, 0), cB + kstep, voffB); PG8_STAGE(PG8_SA(1, 0), cA + kstep, voffA); PG8_STAGE(PG8_SB(1, 1), cB + hstepB + kstep, voffB);
        PG8_WAIT_V(6); PG8_BAR;
    }
    for (;;) {
        const bool has_next = S.next(ui + 1, nxt);
        const char* nA = has_next ? (const char*)g.A + (size_t)nxt.pm * tstepA + g.akoff(nxt.pn) : cA; const char* nB = has_next ? (const char*)g.Bt + (size_t)nxt.pn * tstepB : cB;
        for (int t = 0; t < nt; t += 2) {
            const bool last = (t == nt - 2);
            const char* a1 = cA + (size_t)(t + 1) * kstep;
            const char* a2 = last ? nA : cA + (size_t)(t + 2) * kstep; const char* b2 = last ? nB : cB + (size_t)(t + 2) * kstep;
            const char* a3 = a2 + kstep; const char* b3 = b2 + kstep;
            if (last && has_next) S.a_ready(nxt);
            if constexpr (SP2) {
            PG8_LDB(B0, 0, 0); PG8_LDB(B1, 0, 1); PG8_SCHED; PG8_LDA(At, 0, 0); PG8_STAGE(PG8_SA(1, 1), a1 + hstepA, voffA);
            PG8_WAIT_V(8); PG8_WAIT_L(0); PG8_BAR; PG8_MMA(0, 0, At, B0); PG8_MMA(0, 1, At, B1); PG8_BAR; PG8_SCHED;
            PG8_LDA(At, 0, 1); PG8_STAGE(PG8_SB(0, 0), b2, voffB); PG8_STAGE(PG8_SB(0, 1), b2 + hstepB, voffB); PG8_STAGE(PG8_SA(0, 0), a2, voffA);
            PG8_WAIT_V(8); PG8_WAIT_L(0); PG8_BAR; PG8_MMA(1, 0, At, B0); PG8_MMA(1, 1, At, B1); PG8_BAR; PG8_SCHED;
            PG8_LDB(B0, 1, 0); PG8_LDB(B1, 1, 1); PG8_SCHED; PG8_LDA(At, 1, 0); PG8_STAGE(PG8_SA(0, 1), a2 + hstepA, voffA);
            PG8_WAIT_V(8); PG8_WAIT_L(0); PG8_BAR; PG8_MMA(0, 0, At, B0); PG8_MMA(0, 1, At, B1); PG8_BAR; PG8_SCHED;
            PG8_LDA(At, 1, 1); PG8_STAGE(PG8_SB(1, 0), b3, voffB); PG8_STAGE(PG8_SB(1, 1), b3 + hstepB, voffB); PG8_STAGE(PG8_SA(1, 0), a3, voffA);
            PG8_WAIT_V(8); PG8_WAIT_L(0); PG8_BAR; PG8_MMA(1, 0, At, B0); PG8_MMA(1, 1, At, B1); PG8_BAR; PG8_SCHED;
            } else {
            PG8_LDB(B0, 0, 0); PG8_SCHED; PG8_LDA(At, 0, 0); PG8_STAGE(PG8_SA(1, 1), a1 + hstepA, voffA);
            PG8_WAIT_L(8); PG8_BAR; PG8_WAIT_L(0); PG8_MMA(0, 0, At, B0); PG8_BAR; PG8_SCHED;
            PG8_LDB(B1, 0, 1); PG8_STAGE(PG8_SB(0, 0), b2, voffB);
            PG8_BAR; PG8_WAIT_L(0); PG8_MMA(0, 1, At, B1); PG8_BAR;
            PG8_LDA(At, 0, 1); PG8_STAGE(PG8_SA(0, 0), a2, voffA);
            PG8_BAR; PG8_WAIT_L(0); PG8_MMA(1, 0, At, B0); PG8_BAR; PG8_SCHED;
            PG8_STAGE(PG8_SB(0, 1), b2 + hstepB, voffB);
            PG8_WAIT_V(6); PG8_BAR; PG8_MMA(1, 1, At, B1); PG8_BAR;
            PG8_LDB(B0, 1, 0); PG8_SCHED; PG8_LDA(At, 1, 0); PG8_STAGE(PG8_SA(0, 1), a2 + hstepA, voffA);
            PG8_WAIT_L(8); PG8_BAR; PG8_WAIT_L(0); PG8_MMA(0, 0, At, B0); PG8_BAR; PG8_SCHED;
            PG8_LDB(B1, 1, 1); PG8_STAGE(PG8_SB(1, 0), b3, voffB);
            PG8_BAR; PG8_WAIT_L(0); PG8_MMA(0, 1, At, B1); PG8_BAR;
            PG8_LDA(At, 1, 1); PG8_STAGE(PG8_SA(1, 0), a3, voffA);
            PG8_BAR; PG8_WAIT_L(0); PG8_MMA(1, 0, At, B0); PG8_BAR; PG8_SCHED;
            PG8_STAGE(PG8_SB(1, 1), b3 + hstepB, voffB);
            PG8_WAIT_V(6); PG8_BAR; PG8_MMA(1, 1, At, B1); PG8_BAR;
            }
        }
        if constexpr (ALIGN_EPI) { if (wr == 0) PG8_BAR; }
        if constexpr (!Epi::AFTER_DRAIN) { E(acc, cur, wr, wc, fr, fq); S.done(cur); }
        if (!has_next) break;
#pragma unroll
        for (int a = 0; a < 2; ++a)
#pragma unroll
            for (int b = 0; b < 2; ++b)
#pragma unroll
                for (int m = 0; m < 4; ++m)
#pragma unroll
                    for (int n = 0; n < 2; ++n) acc[a][b][m][n] = (f32x4){0.f, 0.f, 0.f, 0.f};
        cur = nxt; cA = nA; cB = nB; ++ui;
        if constexpr (ALIGN_EPI) { if (wr == 1) PG8_BAR; }
    }
    PG8_WAIT_V(0);
    if constexpr (!ALIGN_EPI) { if (wr == 0) PG8_BAR; }
    PG8_BAR;
    if constexpr (Epi::AFTER_DRAIN) { E.fused(acc, cur, wr, wc, fr, fq, lds, wid, lane); S.done(cur); }
#undef PG8_SA
#undef PG8_SB
#undef PG8_STAGE
#undef PG8_LDA
#undef PG8_LDB
#undef PG8_MMA
#undef PG8_WAIT_V
#undef PG8_WAIT_L
#undef PG8_BAR
#undef PG8_SCHED
}
}
#ifndef MK_N_LAUNCHES
#define MK_N_LAUNCHES 16
#endif
constexpr int NPH = 16;
constexpr int LDS_BYTES = 147456;

struct Args { const float* in[27]; float* out; unsigned char* ws; int ph_lo, ph_hi; };

struct Frame {
    LAS unsigned char* lds;
    int tid, lane, wave, vcu, G;
    const float* const* in;
    float* out; unsigned char* ws;
};
#define WSP(T_, off) ((T_*)(F.ws + (off)))
#define MFMA32(a, b, c) __builtin_amdgcn_mfma_f32_32x32x16_bf16((a), (b), (c), 0, 0, 0)
#define MFMA16(a, b, c) __builtin_amdgcn_mfma_f32_16x16x32_bf16((a), (b), (c), 0, 0, 0)

DI void tr_item(const float* W, int ldw, int k0, int scol0, bf16* WT, int K, int drow0, LAS float* scr, int lane) {
#pragma unroll 8
    for (int i = 0; i < 32; ++i) { const int kk = 2 * i + (lane >> 5); scr[kk * 33 + (lane & 31)] = W[(size_t)(k0 + kk) * ldw + scol0 + (lane & 31)]; }
    asm volatile("s_waitcnt lgkmcnt(0)" ::: "memory");
    const int c = lane & 7;
#pragma unroll
    for (int j = 0; j < 4; ++j) { const int n = (lane >> 3) + 8 * j; const LAS float* s = scr + (8 * c) * 33 + n;
        v4u o; o.x = pk2(s[0 * 33], s[1 * 33]); o.y = pk2(s[2 * 33], s[3 * 33]); o.z = pk2(s[4 * 33], s[5 * 33]); o.w = pk2(s[6 * 33], s[7 * 33]);
        *(v4u*)(WT + (size_t)(drow0 + n) * K + k0 + 8 * c) = o; }
    asm volatile("s_waitcnt lgkmcnt(0)" ::: "memory");
}
DI void p0_prologue(Frame& F) {
    if (F.vcu < 96) {
        const int l = F.vcu / 48, cb = F.vcu % 48, j = cb * 64 + F.lane;
        LAS float* sc = (LAS float*)F.lds;
        const float* c = F.in[1]; const float* cctx = F.in[3];
        for (int i = F.tid; i < 3072; i += NTHR) { const float v = i < 2048 ? c[i] : cctx[i - 2048]; sc[i] = v / (1.f + expf(-v)); }
        __syncthreads();
        const float* wa = F.in[4] + (size_t)l * 1024 * 3072;
        float s0 = 0.f, s1 = 0.f, s2 = 0.f;
#pragma unroll 8
        for (int kk = 0; kk < 128; ++kk) { const int k = F.wave * 128 + kk; const float wv = wa[(size_t)k * 3072 + j]; s0 += sc[k] * wv; s1 += sc[1024 + k] * wv; s2 += sc[2048 + k] * wv; }
        LAS float* pp = sc + 3072;
        pp[(F.wave * 3 + 0) * 64 + F.lane] = s0; pp[(F.wave * 3 + 1) * 64 + F.lane] = s1; pp[(F.wave * 3 + 2) * 64 + F.lane] = s2;
        __syncthreads();
        if (F.tid < 192) { const int cd = F.tid >> 6, ln = F.tid & 63; float s = 0.f;
#pragma unroll
            for (int w = 0; w < 8; ++w) s += pp[(w * 3 + cd) * 64 + ln];
            WSP(float, WS_MOD)[(l * 3 + cd) * 3072 + cb * 64 + ln] = s + F.in[5][l * 3072 + cb * 64 + ln]; }
        __syncthreads();
    } else if (F.vcu < 128) {
        const float* wq = F.in[11]; const float* wk = F.in[12]; const float* wvv = F.in[13];
        const float sK = 0.044194173824159216f;
        for (int idx = (F.vcu - 96) * NTHR + F.tid; idx < 4 * 16 * 1024; idx += 32 * NTHR) {
            const int k = idx & 1023, j16 = (idx >> 10) & 15, h = idx >> 14, dir = j16 >> 3, jj = j16 & 7;
            const float* wg = dir ? F.in[16] : F.in[14];
            const int f = h * 512 + (k & 511), g = f >> 2, i = f & 3; float s = 0.f;
            if (k < 512) {
#pragma unroll
                for (int o = 0; o < 4; ++o) s += wq[g * 16 + i * 4 + o] * wg[(size_t)(4 * g + o) * 8 + jj] + sK * wk[g * 16 + i * 4 + o] * wg[(size_t)(2048 + 4 * g + o) * 8 + jj];
            } else {
#pragma unroll
                for (int o = 0; o < 4; ++o) s += wvv[g * 16 + i * 4 + o] * wg[(size_t)(4096 + 4 * g + o) * 8 + jj];
            }
            WSP(bf16, WS_GT)[idx] = (bf16)(pk2(s, 0.f) & 0xffffu);
        }
        for (int idx = (F.vcu - 96) * NTHR + F.tid; idx < 512 * 16; idx += 32 * NTHR) {
            const int g = idx >> 4, i = (idx >> 2) & 3, i2 = idx & 3; float s = 0.f;
#pragma unroll
            for (int o = 0; o < 4; ++o) s += wq[g * 16 + i * 4 + o] * wk[g * 16 + i2 * 4 + o];
            WSP(float, WS_MQ)[idx] = s * sK;
        }
    }
    LAS float* scr = (LAS float*)(F.lds + 32768 + F.wave * 12288);
    const int gw = F.vcu * NWAVES + F.wave, NGW = F.G * NWAVES;
    constexpr int I_XM = 16 * 64, I_ZO = 16 * 128, I_OA = 32 * 32, I_BIN = 16 * 128, I_POOL = 4 * 8 * 16, I_BOUT = 32 * 32;
    constexpr int NITEMS = I_XM + I_ZO + I_OA + I_BIN + I_POOL + I_BOUT;
    for (int it = gw; it < NITEMS; it += NGW) {
        int r = it;
        if (r < I_XM) { const int kb = r / 64, nb = r % 64; tr_item(F.in[8], 6144, 64 * kb, 32 * nb, WSP(bf16, WS_WXM), 1024, 32 * nb, scr, F.lane); continue; } r -= I_XM;
        if (r < I_ZO) { const int kb = r / 128, nb = r % 128, d0 = 32 * nb, j = d0 >> 8, win = d0 & 255; const int sc0 = (win < 128 ? 2048 : 4096 - 128) + 128 * j + win;
            tr_item(F.in[8], 6144, 64 * kb, sc0, WSP(bf16, WS_WZO), 1024, d0, scr, F.lane); continue; } r -= I_ZO;
        if (r < I_OA) { const int kb = r / 32, nb = r % 32; tr_item(F.in[20], 1024, 64 * kb, 32 * nb, WSP(bf16, WS_WOA), 2048, 32 * nb, scr, F.lane); continue; } r -= I_OA;
        if (r < I_BIN) { const int kb = r / 128, nb = r % 128; tr_item(F.in[23], 4096, 64 * kb, 32 * nb, WSP(bf16, WS_WBIN), 1024, 32 * nb, scr, F.lane); continue; } r -= I_BIN;
        if (r < I_POOL) { const int g = r / 128, q = r % 128, kb = q / 16, nb = q % 16; tr_item(F.in[24] + (size_t)g * 512 * 512, 512, 64 * kb, 32 * nb, WSP(bf16, WS_WPOOL), 512, 512 * g + 32 * nb, scr, F.lane); continue; } r -= I_POOL;
        { const int kb = r / 32, nb = r % 32; tr_item(F.in[26], 1024, 64 * kb, 32 * nb, WSP(bf16, WS_WBOUT), 2048, 32 * nb, scr, F.lane); }
    }
}

DI void modnorm_row(const float* xrow, const float* g, const float* mod, bf16* orow, int lane) {
    f32x4 v[4]; float ss = 0.f;
#pragma unroll
    for (int j = 0; j < 4; ++j) { v[j] = *(const f32x4*)(xrow + 256 * j + 4 * lane); ss += v[j][0] * v[j][0] + v[j][1] * v[j][1] + v[j][2] * v[j][2] + v[j][3] * v[j][3]; }
    const float rstd = 1.f / sqrtf(wave_sum(ss) * (1.f / 1024.f) + EPS);
#pragma unroll
    for (int j = 0; j < 4; ++j) { const int c = 256 * j + 4 * lane; const f32x4 gg = *(const f32x4*)(g + c), sh = *(const f32x4*)(mod + c), sc = *(const f32x4*)(mod + 1024 + c);
        const f32x4 y = v[j] * rstd * gg * (sc + 1.f) + sh; v2u o; o.x = pk2(y[0], y[1]); o.y = pk2(y[2], y[3]); *(v2u*)(orow + c) = o; }
}
DI void p1_hn(Frame& F, bf16* HN, int nrows) {
    const int gw = F.vcu * NWAVES + F.wave, NGW = F.G * NWAVES; const float* mod0 = WSP(float, WS_MOD);
    for (int m = gw; m < nrows; m += NGW) {
        const float* xr = m < M_LAT ? F.in[0] + (size_t)m * 1024 : F.in[2] + (size_t)(m - M_LAT) * 1024;
        const float* mod = mod0 + (m < M_LAT ? (m >> 13) : 2) * 3072;
        modnorm_row(xr, F.in[6], mod, HN + (size_t)m * 1024, F.lane);
    }
}
DI void p7b_rows(Frame& F) {
    const int gw = F.vcu * NWAVES + F.wave, NGW = F.G * NWAVES, lane = F.lane; const float* mod0 = WSP(float, WS_MOD);
    const float* YL = WSP(float, WS_YL); bf16* HN1 = WSP(bf16, WS_HN1);
    for (int m = gw; m < M_LAT; m += NGW) {
        const float* yr = YL + (size_t)m * 1024; const float* xr = F.in[0] + (size_t)m * 1024; const int bb = m >> 13;
        const float* md0 = mod0 + bb * 3072; const float* md1 = mod0 + (3 + bb) * 3072;
        f32x4 v[4]; float ss = 0.f;
#pragma unroll
        for (int j = 0; j < 4; ++j) { v[j] = *(const f32x4*)(yr + 256 * j + 4 * lane); ss += v[j][0] * v[j][0] + v[j][1] * v[j][1] + v[j][2] * v[j][2] + v[j][3] * v[j][3]; }
        const float rstd = 1.f / sqrtf(wave_sum(ss) * (1.f / 1024.f) + EPS); float s1 = 0.f;
#pragma unroll
        for (int j = 0; j < 4; ++j) { const int c = 256 * j + 4 * lane; const f32x4 pg = *(const f32x4*)(F.in[7] + c), gt = *(const f32x4*)(md0 + 2048 + c), xx = *(const f32x4*)(xr + c);
            v[j] = xx + gt * (v[j] * rstd * pg); *(f32x4*)(F.out + (size_t)m * 1024 + c) = v[j];
            s1 += v[j][0] * v[j][0] + v[j][1] * v[j][1] + v[j][2] * v[j][2] + v[j][3] * v[j][3]; }
        const float r1 = 1.f / sqrtf(wave_sum(s1) * (1.f / 1024.f) + EPS);
#pragma unroll
        for (int j = 0; j < 4; ++j) { const int c = 256 * j + 4 * lane; const f32x4 gg = *(const f32x4*)(F.in[21] + c), sh = *(const f32x4*)(md1 + c), sc = *(const f32x4*)(md1 + 1024 + c);
            const f32x4 y = v[j] * r1 * gg * (sc + 1.f) + sh; v2u o; o.x = pk2(y[0], y[1]); o.y = pk2(y[2], y[3]); *(v2u*)(HN1 + (size_t)m * 1024 + c) = o; }
    }
}
DI void p11b_rows(Frame& F) {
    const int gw = F.vcu * NWAVES + F.wave, NGW = F.G * NWAVES, lane = F.lane; const float* mod0 = WSP(float, WS_MOD);
    const float* YL = WSP(float, WS_YL1);
    for (int m = gw; m < M_LAT; m += NGW) {
        const float* yr = YL + (size_t)m * 1024; const float* md1 = mod0 + (3 + (m >> 13)) * 3072;
        f32x4 v[4]; float ss = 0.f;
#pragma unroll
        for (int j = 0; j < 4; ++j) { v[j] = *(const f32x4*)(yr + 256 * j + 4 * lane); ss += v[j][0] * v[j][0] + v[j][1] * v[j][1] + v[j][2] * v[j][2] + v[j][3] * v[j][3]; }
        const float rstd = 1.f / sqrtf(wave_sum(ss) * (1.f / 1024.f) + EPS);
#pragma unroll
        for (int j = 0; j < 4; ++j) { const int c = 256 * j + 4 * lane; const f32x4 pg = *(const f32x4*)(F.in[22] + c), gt = *(const f32x4*)(md1 + 2048 + c);
            float* op = F.out + (size_t)m * 1024 + c; const f32x4 xx = *(const f32x4*)op; *(f32x4*)op = xx + gt * (v[j] * rstd * pg); }
    }
}
DI void p5b_stats(Frame& F) {
    const int gw = F.vcu * NWAVES + F.wave, NGW = F.G * NWAVES, lane = F.lane;
    const bf16* Hs = WSP(bf16, WS_H); float* st = WSP(float, WS_ST);
    for (int it = gw; it < M_LAT * 4; it += NGW) {
        const int row = it >> 2, h = it & 3; const v4u hv = *(const v4u*)(Hs + (size_t)row * 2048 + h * 512 + 8 * lane);
        float x[8] = {bflo(hv.x), bfhi(hv.x), bflo(hv.y), bfhi(hv.y), bflo(hv.z), bfhi(hv.z), bflo(hv.w), bfhi(hv.w)};
        float s = 0.f;
#pragma unroll
        for (int i = 0; i < 8; ++i) s += x[i];
        const float mean = wave_sum(s) * (1.f / 512.f); float q = 0.f;
#pragma unroll
        for (int i = 0; i < 8; ++i) { const float d = x[i] - mean; q += d * d; }
        const float rstd = 1.f / sqrtf(wave_sum(q) * (1.f / 512.f) + EPS);
        if (lane == 0) { st[(size_t)row * 8 + 2 * h] = mean; st[(size_t)row * 8 + 2 * h + 1] = rstd; }
    }
    p1_hn(F, WSP(bf16, WS_HN2), M_LAT);
}

DI void p3_conv(Frame& F) {
    const int w = F.wave, lane = F.lane, fr = lane & 15, fq = lane >> 4;
    LAS unsigned char* XCs = F.lds; LAS unsigned char* Qs = F.lds + 33792; LAS unsigned char* XMs = F.lds + 67584; LAS float* QKs = (LAS float*)F.lds;
    const float* convw = F.in[9]; const float* convb = F.in[10]; const float* MQ = WSP(float, WS_MQ); const bf16* GT = WSP(bf16, WS_GT);
    for (int tile = F.vcu; tile < NCC * 4; tile += F.G) {
        const int cc = tile >> 2, h = tile & 3; const bool lat = cc < 256;
        const int cloc = lat ? (cc & 127) : ((cc - 256) & 3), clast = lat ? 127 : 3;
        const int rowbase = lat ? ((cc >> 7) * 8192 + cloc * 64) : (((cc - 256) >> 2) * 256 + cloc * 64);
        const bf16* XMb = lat ? (const bf16*)F.out : WSP(bf16, WS_XMC);
        const int grow0 = lat ? rowbase : M_LAT + rowbase;
        bf16* QAt = WSP(bf16, WS_QA) + (size_t)tile * 32768; bf16* KAt = WSP(bf16, WS_KA) + (size_t)tile * 32768;
        f32x4 qk0 = {0.f, 0.f, 0.f, 0.f}, qk1 = {0.f, 0.f, 0.f, 0.f}, ga = {0.f, 0.f, 0.f, 0.f};
#pragma unroll 1
        for (int half = 0; half < 2; ++half) {
            const int fl = half * 256 + 4 * lane, f = h * 512 + fl;
            const f32x4 cw0 = *(const f32x4*)(convw + f), cw1 = *(const f32x4*)(convw + 2048 + f), cw2 = *(const f32x4*)(convw + 4096 + f), cbv = *(const f32x4*)(convb + f);
            f32x4 mq[4];
#pragma unroll
            for (int i = 0; i < 4; ++i) mq[i] = *(const f32x4*)(MQ + (f >> 2) * 16 + 4 * i);
            v2u xr[10];
#pragma unroll
            for (int i = 0; i < 10; ++i) { const int r = 8 * w - 1 + i; const bool ok = (r >= 0 || cloc > 0) && (r < 64 || cloc < clast);
                xr[i] = (v2u){0u, 0u}; if (ok) xr[i] = *(const v2u*)(XMb + (size_t)(rowbase + r) * 2048 + f); }
            unsigned ka[4][4], tmp[4] = {0u, 0u, 0u, 0u};
            const int wq_ = fl >> 6, ksq = (fl >> 4) & 3, r16 = fl & 15, hq = (r16 >> 2) & 1, jg = r16 >> 3;
#pragma unroll
            for (int tt = 0; tt < 8; ++tt) {
                const float x0[4] = {bflo(xr[tt].x), bfhi(xr[tt].x), bflo(xr[tt].y), bfhi(xr[tt].y)};
                const float x1[4] = {bflo(xr[tt + 1].x), bfhi(xr[tt + 1].x), bflo(xr[tt + 1].y), bfhi(xr[tt + 1].y)};
                const float x2[4] = {bflo(xr[tt + 2].x), bfhi(xr[tt + 2].x), bflo(xr[tt + 2].y), bfhi(xr[tt + 2].y)};
                float xc[4];
#pragma unroll
                for (int o = 0; o < 4; ++o) xc[o] = siluf_(cw0[o] * x0[o] + cw1[o] * x1[o] + cw2[o] * x2[o] + cbv[o]);
                float qt[4];
#pragma unroll
                for (int i2 = 0; i2 < 4; ++i2) qt[i2] = xc[0] * mq[0][i2] + xc[1] * mq[1][i2] + xc[2] * mq[2][i2] + xc[3] * mq[3][i2];
                const v2u xcb = (v2u){pk2(xc[0], xc[1]), pk2(xc[2], xc[3])}, qb = (v2u){pk2(qt[0], qt[1]), pk2(qt[2], qt[3])};
                const int t = 8 * w + tt; const int lo = (t * 264 + 4 * lane) * 2;
                *(LAS v2u*)(XCs + lo) = xcb; *(LAS v2u*)(Qs + lo) = qb; *(LAS v2u*)(XMs + lo) = xr[tt + 1];
                *(v2u*)(QAt + ((((wq_ * 2 + (t >> 5)) * 4 + ksq) * 64 + (t & 31) + 32 * hq) * 8 + jg * 4)) = qb;
                const unsigned b0 = xcb.x & 0xffffu, b1 = xcb.x >> 16, b2 = xcb.y & 0xffffu, b3 = xcb.y >> 16;
                if ((tt & 1) == 0) { tmp[0] = b0; tmp[1] = b1; tmp[2] = b2; tmp[3] = b3; }
                else { ka[0][tt >> 1] = tmp[0] | (b0 << 16); ka[1][tt >> 1] = tmp[1] | (b1 << 16); ka[2][tt >> 1] = tmp[2] | (b2 << 16); ka[3][tt >> 1] = tmp[3] | (b3 << 16); }
            }
#pragma unroll
            for (int o = 0; o < 4; ++o) { const int d = fl + o; *(v4u*)(KAt + ((((d >> 5) * 4 + (w >> 1)) * 64 + (d & 31) + 32 * (w & 1)) * 8)) = (v4u){ka[o][0], ka[o][1], ka[o][2], ka[o][3]}; }
            __syncthreads();
            const int mt_ = w >> 1, nt0 = 2 * (w & 1);
#pragma unroll
            for (int ks = 0; ks < 8; ++ks) {
                const bf16x8 a = *(const LAS bf16x8*)(Qs + ((16 * mt_ + fr) * 264 + 32 * ks + 8 * fq) * 2);
                const bf16x8 b0 = *(const LAS bf16x8*)(XCs + ((16 * nt0 + fr) * 264 + 32 * ks + 8 * fq) * 2);
                const bf16x8 b1 = *(const LAS bf16x8*)(XCs + ((16 * (nt0 + 1) + fr) * 264 + 32 * ks + 8 * fq) * 2);
                qk0 = MFMA16(a, b0, qk0); qk1 = MFMA16(a, b1, qk1);
            }
            if (w < 4) {
#pragma unroll
                for (int ks = 0; ks < 8; ++ks) {
                    const bf16x8 a1 = *(const LAS bf16x8*)(XCs + ((16 * w + fr) * 264 + 32 * ks + 8 * fq) * 2);
                    const bf16x8 a2 = *(const LAS bf16x8*)(XMs + ((16 * w + fr) * 264 + 32 * ks + 8 * fq) * 2);
                    const bf16x8 g1 = *(const bf16x8*)(GT + ((h * 16 + fr) * 1024 + half * 256 + 32 * ks + 8 * fq));
                    const bf16x8 g2 = *(const bf16x8*)(GT + ((h * 16 + fr) * 1024 + 512 + half * 256 + 32 * ks + 8 * fq));
                    ga = MFMA16(a1, g1, ga); ga = MFMA16(a2, g2, ga);
                }
            }
            __syncthreads();
        }
        {   const int mt_ = w >> 1, nt0 = 2 * (w & 1);
#pragma unroll
            for (int r = 0; r < 4; ++r) { QKs[(16 * mt_ + 4 * fq + r) * 65 + 16 * nt0 + fr] = qk0[r]; QKs[(16 * mt_ + 4 * fq + r) * 65 + 16 * (nt0 + 1) + fr] = qk1[r]; }
            if (w < 4) { float* GP = WSP(float, WS_GP) + ((size_t)h * M_ALL + grow0 + 16 * w + 4 * fq) * 16 + fr;
#pragma unroll
                for (int r = 0; r < 4; ++r) GP[r * 16] = ga[r]; }
        }
        __syncthreads();
        {   const int t = 32 * (w >> 2) + (lane & 31), s0 = 16 * (w & 3) + 8 * (lane >> 5); const LAS float* q = QKs + t * 65 + s0;
            *(v4u*)(WSP(bf16, WS_QK) + (size_t)tile * 4096 + (w * 64 + lane) * 8) = (v4u){pk2(q[0], q[1]), pk2(q[2], q[3]), pk2(q[4], q[5]), pk2(q[6], q[7])}; }
        __syncthreads();
    }
}

DI void p3c_gates(Frame& F) {
    const int gw = F.vcu * NWAVES + F.wave, NGW = F.G * NWAVES, lane = F.lane;
    const float* GP = WSP(float, WS_GP); float* GS = WSP(float, WS_GS); float* GC = WSP(float, WS_GC);
    for (int gi = gw; gi < NCC * 8; gi += NGW) {
        const int dir = gi & 1, h = (gi >> 1) & 3, cc = gi >> 3;
        const int grow = (cc < 256 ? cc * 64 : M_LAT + (cc - 256) * 64) + lane;
        const float* bias = dir ? F.in[17] : F.in[15];
        float pi = bias[h], pf = bias[4 + h];
#pragma unroll
        for (int hp = 0; hp < 4; ++hp) { pi += GP[((size_t)hp * M_ALL + grow) * 16 + dir * 8 + h]; pf += GP[((size_t)hp * M_ALL + grow) * 16 + dir * 8 + 4 + h]; }
        const float lf = fminf(pf, 0.f) - log1pf(expf(-fabsf(pf)));
        float bc = lf;
        if (dir == 0) {
#pragma unroll
            for (int o = 1; o < 64; o <<= 1) { const float v = __shfl_up(bc, o); if (lane >= o) bc += v; }
        } else {
#pragma unroll
            for (int o = 1; o < 64; o <<= 1) { const float v = __shfl_down(bc, o); if (lane + o < 64) bc += v; }
        }
        const float beta = pi - bc; float cm = beta;
        if (dir == 0) {
#pragma unroll
            for (int o = 1; o < 64; o <<= 1) { const float v = __shfl_up(cm, o); if (lane >= o) cm = fmaxf(cm, v); }
        } else {
#pragma unroll
            for (int o = 1; o < 64; o <<= 1) { const float v = __shfl_down(cm, o); if (lane + o < 64) cm = fmaxf(cm, v); }
        }
        const float mi = bc + cm;
        const float blast = __shfl(bc, dir ? 0 : 63), maxb = __shfl(cm, dir ? 0 : 63);
        const bf16* qkt = WSP(bf16, WS_QK) + (size_t)(cc * 4 + h) * 4096; const int t = lane; float den = 0.f;
#pragma unroll
        for (int ks = 0; ks < 4; ++ks)
#pragma unroll
            for (int hh = 0; hh < 2; ++hh) {
                const v4u q = *(const v4u*)(qkt + ((((t >> 5) * 4 + ks) * 64) + (t & 31) + 32 * hh) * 8);
                const float qv[8] = {bflo(q.x), bfhi(q.x), bflo(q.y), bfhi(q.y), bflo(q.z), bfhi(q.z), bflo(q.w), bfhi(q.w)};
#pragma unroll
                for (int j = 0; j < 8; ++j) { const int s = 16 * ks + 8 * hh + j; const float bs = __shfl(beta, s);
                    const bool ok = dir ? (s >= t) : (s <= t); const float e = __expf(bc + bs - mi); den += ok ? qv[j] * e : 0.f; }
            }
        float* gs = GS + (size_t)gi * 256;
        gs[lane] = bc; gs[64 + lane] = beta; gs[128 + lane] = mi; gs[192 + lane] = den;
        if (lane == 0) { GC[gi * 2] = blast; GC[gi * 2 + 1] = maxb; }
    }
}

DI void scan_phase(Frame& F, cg::grid_group& grid) {
    const int bid = blockIdx.x, xcd = bid & 7, slot = bid >> 3;
    const int sidx = xcd * 2 + (slot >> 4), es = slot & 15, b = sidx >> 3, h = (sidx >> 1) & 3, dir = sidx & 1;
    const int w = F.wave, lane = F.lane, tid = F.tid, r32 = lane & 31, hh = lane >> 5;
    LAS float* PART = (LAS float*)F.lds;
    LAS float* DP = (LAS float*)(F.lds + 69632);
    LAS float* NV = (LAS float*)(F.lds + 71680);
    LAS unsigned char* Vt = F.lds + 73728; LAS unsigned char* Vu = F.lds + 77824;
    LAS float* TAB = (LAS float*)(F.lds + 81920);
    const bf16* QAg = WSP(bf16, WS_QA); const bf16* KAg = WSP(bf16, WS_KA); const bf16* QKg = WSP(bf16, WS_QK);
    const float* GS = WSP(float, WS_GS); const float* GC = WSP(float, WS_GC); bf16* Hs = WSP(bf16, WS_H);
    const int tV = tid >> 3, pV = tid & 7;
    float wv[16];
    { const float* p = F.in[13] + (size_t)(((h * 512 + 32 * es) >> 2) + pV) * 16;
#pragma unroll
      for (int i = 0; i < 4; ++i) { const f32x4 v = *(const f32x4*)(p + 4 * i); wv[4 * i] = v[0]; wv[4 * i + 1] = v[1]; wv[4 * i + 2] = v[2]; wv[4 * i + 3] = v[3]; } }
    f32x16 Cs0, Cs1;
#pragma unroll
    for (int i = 0; i < 16; ++i) { Cs0[i] = 0.f; Cs1[i] = 0.f; }
    float m_prev = 0.f;
    NV[w * 64 + lane] = 0.f;
#define STEP_ADDR(k_, cc_, xmrow_, lat_) do { if ((k_) < 4) { const int cl_ = dir ? 3 - (k_) : (k_); cc_ = 256 + b * 4 + cl_; lat_ = false; xmrow_ = b * 256 + cl_ * 64; } \
        else { const int kk_ = (k_) - 4; const int cl_ = dir ? 127 - kk_ : kk_; cc_ = b * 128 + cl_; lat_ = true; xmrow_ = b * 8192 + cl_ * 64; } } while (0)
    bf16x8 QAf[2][4], KAf[2][4]; v4u qkf; v2u xmv; float betat, g_b = 0.f, g_beta = 0.f, g_mi = 0.f, g_dn = 0.f, blast, maxb;
#define LOAD_SMALL(k_) do { int cc_, xr_; bool lt_; STEP_ADDR(k_, cc_, xr_, lt_); const int ti_ = cc_ * 4 + h, gi_ = ti_ * 2 + dir; \
        qkf = *(const v4u*)(QKg + (size_t)ti_ * 4096 + (w * 64 + lane) * 8); \
        xmv = *(const v2u*)((lt_ ? (const bf16*)F.out : WSP(bf16, WS_XMC)) + (size_t)(xr_ + tV) * 2048 + h * 512 + 32 * es + 4 * pV); \
        betat = GS[(size_t)gi_ * 256 + 64 + tV]; blast = GC[gi_ * 2]; maxb = GC[gi_ * 2 + 1]; \
        if (w == 0) { g_b = GS[(size_t)gi_ * 256 + lane]; g_beta = GS[(size_t)gi_ * 256 + 64 + lane]; g_mi = GS[(size_t)gi_ * 256 + 128 + lane]; g_dn = GS[(size_t)gi_ * 256 + 192 + lane]; } } while (0)
#define LOAD_QA(k_) do { int cc_, xr_; bool lt_; STEP_ADDR(k_, cc_, xr_, lt_); const bf16* p_ = QAg + (size_t)(cc_ * 4 + h) * 32768 + (size_t)(w * 8) * 512 + lane * 8; \
        _Pragma("unroll") for (int mt_ = 0; mt_ < 2; ++mt_) _Pragma("unroll") for (int ks_ = 0; ks_ < 4; ++ks_) QAf[mt_][ks_] = *(const bf16x8*)(p_ + (mt_ * 4 + ks_) * 512); } while (0)
#define LOAD_KA(k_) do { int cc_, xr_; bool lt_; STEP_ADDR(k_, cc_, xr_, lt_); const bf16* p_ = KAg + (size_t)(cc_ * 4 + h) * 32768 + (size_t)(w * 8) * 512 + lane * 8; \
        _Pragma("unroll") for (int tp_ = 0; tp_ < 2; ++tp_) _Pragma("unroll") for (int j_ = 0; j_ < 4; ++j_) KAf[tp_][j_] = *(const bf16x8*)(p_ + (tp_ * 4 + j_) * 512); } while (0)
    LOAD_SMALL(0); LOAD_QA(0); LOAD_KA(0);
    __syncthreads();
#pragma unroll 1
    for (int k = 0; k < 132; ++k) {
        if (k == 68) grid.sync();
        int cc, xmrow; bool lat; STEP_ADDR(k, cc, xmrow, lat);
        LAS float* TB = TAB + (k & 1) * 384;
        const float m_new = fmaxf(blast + m_prev, blast + maxb), decay = __expf(blast + m_prev - m_new);
        if (w == 0) {
            const float mt = fmaxf(g_b + m_prev, g_mi);
            TB[lane] = g_b - mt; TB[64 + lane] = __expf(g_b + m_prev - mt); TB[128 + lane] = g_dn * __expf(g_mi - mt); TB[192 + lane] = __expf(-mt);
            TB[256 + lane] = g_beta; TB[320 + lane] = __expf(blast + g_beta - m_new);
        }
        {   const float x4[4] = {bflo(xmv.x), bfhi(xmv.x), bflo(xmv.y), bfhi(xmv.y)}; const float wg = __expf(blast + betat - m_new);
            const int vo = (tV >> 4) * 1024 + (32 * ((tV >> 3) & 1)) * 16 + (tV & 7) * 2;
#pragma unroll
            for (int o = 0; o < 4; ++o) { const float v = x4[0] * wv[o] + x4[1] * wv[4 + o] + x4[2] * wv[8 + o] + x4[3] * wv[12 + o];
                const int a = vo + (4 * pV + o) * 16;
                *(LAS bf16*)(Vt + a) = (bf16)(pk2(v, 0.f) & 0xffffu); *(LAS bf16*)(Vu + a) = (bf16)(pk2(v * wg, 0.f) & 0xffffu); }
        }
        const v4u qkc = qkf;
        if (k + 1 < 132) LOAD_SMALL(k + 1);
        __syncthreads();
        f32x16 acc0, acc1;
#pragma unroll
        for (int i = 0; i < 16; ++i) { acc0[i] = 0.f; acc1[i] = 0.f; }
        {   bf16x8 cb[4];
#pragma unroll
            for (int s = 0; s < 2; ++s) {
                cb[s] = __builtin_bit_cast(bf16x8, (v4u){pk2(Cs0[8 * s], Cs0[8 * s + 1]), pk2(Cs0[8 * s + 2], Cs0[8 * s + 3]), pk2(Cs0[8 * s + 4], Cs0[8 * s + 5]), pk2(Cs0[8 * s + 6], Cs0[8 * s + 7])});
                cb[2 + s] = __builtin_bit_cast(bf16x8, (v4u){pk2(Cs1[8 * s], Cs1[8 * s + 1]), pk2(Cs1[8 * s + 2], Cs1[8 * s + 3]), pk2(Cs1[8 * s + 4], Cs1[8 * s + 5]), pk2(Cs1[8 * s + 6], Cs1[8 * s + 7])}); }
#pragma unroll
            for (int ks = 0; ks < 4; ++ks) { acc0 = MFMA32(QAf[0][ks], cb[ks], acc0); acc1 = MFMA32(QAf[1][ks], cb[ks], acc1); }
        }
        {   float d0 = 0.f, d1 = 0.f;
#pragma unroll
            for (int ks = 0; ks < 4; ++ks) {
                const f32x4 na = *(const LAS f32x4*)(NV + w * 64 + 16 * ks + 4 * hh), nb = *(const LAS f32x4*)(NV + w * 64 + 16 * ks + 8 + 4 * hh);
                const v4u q0 = __builtin_bit_cast(v4u, QAf[0][ks]), q1 = __builtin_bit_cast(v4u, QAf[1][ks]);
                d0 += bflo(q0.x) * na[0] + bfhi(q0.x) * na[1] + bflo(q0.y) * na[2] + bfhi(q0.y) * na[3] + bflo(q0.z) * nb[0] + bfhi(q0.z) * nb[1] + bflo(q0.w) * nb[2] + bfhi(q0.w) * nb[3];
                d1 += bflo(q1.x) * na[0] + bfhi(q1.x) * na[1] + bflo(q1.y) * na[2] + bfhi(q1.y) * na[3] + bflo(q1.z) * nb[0] + bfhi(q1.z) * nb[1] + bflo(q1.w) * nb[2] + bfhi(q1.w) * nb[3];
            }
            d0 += __shfl_xor(d0, 32); d1 += __shfl_xor(d1, 32);
            if (hh == 0) { DP[r32 * 8 + w] = d0 * TB[64 + r32]; DP[(32 + r32) * 8 + w] = d1 * TB[64 + 32 + r32]; }
        }
        if (k + 1 < 132) LOAD_QA(k + 1);
#pragma unroll
        for (int q = 0; q < 4; ++q) { const f32x4 e0 = *(const LAS f32x4*)(TB + 64 + 8 * q + 4 * hh), e1 = *(const LAS f32x4*)(TB + 64 + 32 + 8 * q + 4 * hh);
#pragma unroll
            for (int i = 0; i < 4; ++i) { acc0[4 * q + i] *= e0[i]; acc1[4 * q + i] *= e1[i]; } }
        {   const int mtw = w >> 2, ksw = w & 3, t = 32 * mtw + r32, s0 = 16 * ksw + 8 * hh;
            const float ta = TB[t]; const f32x4 ba = *(const LAS f32x4*)(TB + 256 + s0), bb = *(const LAS f32x4*)(TB + 256 + s0 + 4);
            const float qv[8] = {bflo(qkc.x), bfhi(qkc.x), bflo(qkc.y), bfhi(qkc.y), bflo(qkc.z), bfhi(qkc.z), bflo(qkc.w), bfhi(qkc.w)};
            const float be[8] = {ba[0], ba[1], ba[2], ba[3], bb[0], bb[1], bb[2], bb[3]};
            float sv[8];
#pragma unroll
            for (int j = 0; j < 8; ++j) { const int s = s0 + j; const bool ok = dir ? (s >= t) : (s <= t); const float e = __expf(ta + be[j]); sv[j] = ok ? qv[j] * e : 0.f; }
            const bf16x8 sf = __builtin_bit_cast(bf16x8, (v4u){pk2(sv[0], sv[1]), pk2(sv[2], sv[3]), pk2(sv[4], sv[5]), pk2(sv[6], sv[7])});
            const bf16x8 vf = *(const LAS bf16x8*)(Vt + ksw * 1024 + lane * 16);
            if (mtw == 0) acc0 = MFMA32(sf, vf, acc0); else acc1 = MFMA32(sf, vf, acc1);
        }
#pragma unroll
        for (int q = 0; q < 4; ++q) {
            *(LAS f32x4*)(PART + (w * 32 + r32) * 68 + 8 * q + 4 * hh) = (f32x4){acc0[4 * q], acc0[4 * q + 1], acc0[4 * q + 2], acc0[4 * q + 3]};
            *(LAS f32x4*)(PART + (w * 32 + r32) * 68 + 32 + 8 * q + 4 * hh) = (f32x4){acc1[4 * q], acc1[4 * q + 1], acc1[4 * q + 2], acc1[4 * q + 3]}; }
#pragma unroll
        for (int i = 0; i < 16; ++i) { Cs0[i] *= decay; Cs1[i] *= decay; }
#pragma unroll
        for (int j = 0; j < 4; ++j) { const bf16x8 vf = *(const LAS bf16x8*)(Vu + j * 1024 + lane * 16); Cs0 = MFMA32(KAf[0][j], vf, Cs0); Cs1 = MFMA32(KAf[1][j], vf, Cs1); }
        {   float p0 = 0.f, p1 = 0.f;
#pragma unroll
            for (int j = 0; j < 4; ++j) {
                const f32x4 wa = *(const LAS f32x4*)(TB + 320 + 16 * j + 8 * hh), wb = *(const LAS f32x4*)(TB + 320 + 16 * j + 8 * hh + 4);
                const v4u k0 = __builtin_bit_cast(v4u, KAf[0][j]), k1 = __builtin_bit_cast(v4u, KAf[1][j]);
                p0 += bflo(k0.x) * wa[0] + bfhi(k0.x) * wa[1] + bflo(k0.y) * wa[2] + bfhi(k0.y) * wa[3] + bflo(k0.z) * wb[0] + bfhi(k0.z) * wb[1] + bflo(k0.w) * wb[2] + bfhi(k0.w) * wb[3];
                p1 += bflo(k1.x) * wa[0] + bfhi(k1.x) * wa[1] + bflo(k1.y) * wa[2] + bfhi(k1.y) * wa[3] + bflo(k1.z) * wb[0] + bfhi(k1.z) * wb[1] + bflo(k1.w) * wb[2] + bfhi(k1.w) * wb[3];
            }
            p0 += __shfl_xor(p0, 32); p1 += __shfl_xor(p1, 32);
            if (hh == 0) { NV[w * 64 + r32] = decay * NV[w * 64 + r32] + p0; NV[w * 64 + 32 + r32] = decay * NV[w * 64 + 32 + r32] + p1; }
        }
        if (k + 1 < 132) LOAD_KA(k + 1);
        __syncthreads();
        if (lat) {
            const int e = tid & 31, tq = tid >> 5; f32x4 num = {0.f, 0.f, 0.f, 0.f};
#pragma unroll
            for (int ww = 0; ww < 8; ++ww) num += *(const LAS f32x4*)(PART + (ww * 32 + e) * 68 + 4 * tq);
            bf16* hp = Hs + (size_t)(xmrow + 4 * tq) * 2048 + h * 512 + 32 * es + e; const bool second = (k >= 68);
#pragma unroll
            for (int i = 0; i < 4; ++i) { const int t = 4 * tq + i; const f32x4 da = *(const LAS f32x4*)(DP + t * 8), db = *(const LAS f32x4*)(DP + t * 8 + 4);
                const float den = TB[128 + t] + ((da[0] + da[1]) + (da[2] + da[3])) + ((db[0] + db[1]) + (db[2] + db[3]));
                float hv = num[i] / fmaxf(fabsf(den), TB[192 + t]);
                if (second) hv += __uint_as_float((unsigned)hp[(size_t)i * 2048] << 16);
                hp[(size_t)i * 2048] = (bf16)(pk2(hv, 0.f) & 0xffffu); }
        }
        m_prev = m_new;
    }
#undef STEP_ADDR
#undef LOAD_SMALL
#undef LOAD_QA
#undef LOAD_KA
}

DI void p9a_cols(Frame& F) {
    const bf16* U = WSP(bf16, WS_U); bf16* M1 = WSP(bf16, WS_M1);
    for (int task = F.vcu * NTHR + F.tid; task < 2 * 128 * 2 * 256; task += F.G * NTHR) {
        const int fc = task & 255, half = (task >> 8) & 1, r = (task >> 9) & 127, bb = task >> 16;
        const int g = fc >> 6, wdw = 2 << g, lo_off = wdw >> 1, hi_off = wdw - lo_off;
        const bf16* up = U + ((size_t)(bb * 8192 + r * 64)) * 2048 + fc * 8; bf16* mp = M1 + ((size_t)(bb * 8192 + r * 64)) * 2048 + fc * 8;
        const int cs = half * 32; float S[8] = {0.f, 0.f, 0.f, 0.f, 0.f, 0.f, 0.f, 0.f};
        { const int lo = cs - lo_off < 0 ? 0 : cs - lo_off, hi = cs + hi_off > 64 ? 64 : cs + hi_off;
          for (int c = lo; c < hi; ++c) { const v4u v = *(const v4u*)(up + (size_t)c * 2048);
              S[0] += bflo(v.x); S[1] += bfhi(v.x); S[2] += bflo(v.y); S[3] += bfhi(v.y); S[4] += bflo(v.z); S[5] += bfhi(v.z); S[6] += bflo(v.w); S[7] += bfhi(v.w); } }
        for (int c = cs; c < cs + 32; ++c) {
            const int lo = c - lo_off < 0 ? 0 : c - lo_off, hi = c + hi_off > 64 ? 64 : c + hi_off; const float inv = 1.f / (float)(hi - lo);
            *(v4u*)(mp + (size_t)c * 2048) = (v4u){pk2(S[0] * inv, S[1] * inv), pk2(S[2] * inv, S[3] * inv), pk2(S[4] * inv, S[5] * inv), pk2(S[6] * inv, S[7] * inv)};
            if (c + hi_off < 64) { const v4u v = *(const v4u*)(up + (size_t)(c + hi_off) * 2048);
                S[0] += bflo(v.x); S[1] += bfhi(v.x); S[2] += bflo(v.y); S[3] += bfhi(v.y); S[4] += bflo(v.z); S[5] += bfhi(v.z); S[6] += bflo(v.w); S[7] += bfhi(v.w); }
            if (c - lo_off >= 0) { const v4u v = *(const v4u*)(up + (size_t)(c - lo_off) * 2048);
                S[0] -= bflo(v.x); S[1] -= bfhi(v.x); S[2] -= bflo(v.y); S[3] -= bfhi(v.y); S[4] -= bflo(v.z); S[5] -= bfhi(v.z); S[6] -= bflo(v.w); S[7] -= bfhi(v.w); }
        }
    }
}
DI void p9b_rows(Frame& F) {
    bf16* U = WSP(bf16, WS_U); const bf16* M1 = WSP(bf16, WS_M1);
    for (int task = F.vcu * NTHR + F.tid; task < 2 * 64 * 4 * 256; task += F.G * NTHR) {
        const int fc = task & 255, qr = (task >> 8) & 3, c = (task >> 10) & 63, bb = task >> 16;
        const int g = fc >> 6, wdw = 2 << g, lo_off = wdw >> 1, hi_off = wdw - lo_off;
        const bf16* mp = M1 + ((size_t)(bb * 8192 + c)) * 2048 + fc * 8; bf16* up = U + ((size_t)(bb * 8192 + c)) * 2048 + fc * 8;
        const int rs = qr * 32; float S[8] = {0.f, 0.f, 0.f, 0.f, 0.f, 0.f, 0.f, 0.f};
        { const int lo = rs - lo_off < 0 ? 0 : rs - lo_off, hi = rs + hi_off > 128 ? 128 : rs + hi_off;
          for (int r = lo; r < hi; ++r) { const v4u v = *(const v4u*)(mp + (size_t)r * 64 * 2048);
              S[0] += bflo(v.x); S[1] += bfhi(v.x); S[2] += bflo(v.y); S[3] += bfhi(v.y); S[4] += bflo(v.z); S[5] += bfhi(v.z); S[6] += bflo(v.w); S[7] += bfhi(v.w); } }
        for (int r = rs; r < rs + 32; ++r) {
            const int lo = r - lo_off < 0 ? 0 : r - lo_off, hi = r + hi_off > 128 ? 128 : r + hi_off; const float inv = 1.f / (float)(hi - lo);
            const v4u uv = *(const v4u*)(up + (size_t)r * 64 * 2048);
            *(v4u*)(up + (size_t)r * 64 * 2048) = (v4u){pk2(S[0] * inv - bflo(uv.x), S[1] * inv - bfhi(uv.x)), pk2(S[2] * inv - bflo(uv.y), S[3] * inv - bfhi(uv.y)),
                                                      pk2(S[4] * inv - bflo(uv.z), S[5] * inv - bfhi(uv.z)), pk2(S[6] * inv - bflo(uv.w), S[7] * inv - bfhi(uv.w))};
            if (r + hi_off < 128) { const v4u v = *(const v4u*)(mp + (size_t)(r + hi_off) * 64 * 2048);
                S[0] += bflo(v.x); S[1] += bfhi(v.x); S[2] += bflo(v.y); S[3] += bfhi(v.y); S[4] += bflo(v.z); S[5] += bfhi(v.z); S[6] += bflo(v.w); S[7] += bfhi(v.w); }
            if (r - lo_off >= 0) { const v4u v = *(const v4u*)(mp + (size_t)(r - lo_off) * 64 * 2048);
                S[0] -= bflo(v.x); S[1] -= bfhi(v.x); S[2] -= bflo(v.y); S[3] -= bfhi(v.y); S[4] -= bflo(v.z); S[5] -= bfhi(v.z); S[6] -= bflo(v.w); S[7] -= bfhi(v.w); }
        }
    }
}
__global__ void __launch_bounds__(NTHR, 2) mk_fwd(Args args) {
    extern __shared__ __attribute__((aligned(16))) unsigned char lds_raw[];
    cg::grid_group grid = cg::this_grid();
    Frame F;
    F.lds = (LAS unsigned char*)lds_raw;
    F.tid = threadIdx.x; F.lane = F.tid & 63; F.wave = __builtin_amdgcn_readfirstlane(F.tid >> 6);
    F.G = gridDim.x; { const int bx = blockIdx.x; F.vcu = (F.G % 8 == 0) ? (bx % 8) * (F.G / 8) + bx / 8 : bx; }
    F.in = args.in; F.out = args.out; F.ws = args.ws;
    const int lo = args.ph_lo, hi = args.ph_hi;
#define IN(k) (lo <= (k) && (k) < hi)
#define SEAM(k) do { if (IN(k) && IN((k) + 1)) grid.sync(); } while (0)
    typedef pg8::bf16_t pbf;
    if (IN(0)) { p0_prologue(F); } SEAM(0);
    if (IN(1)) { p1_hn(F, WSP(bf16, WS_HN), M_ALL); } SEAM(1);
    if (IN(2)) {
        pg8::Gemm g{WSP(pbf, WS_HN), WSP(pbf, WS_WXM), M_ALL, 2048, 1024, 1024, 1024, -1}; pg8::StaticOrder S; S.init(M_ALL, 2048, F.G, (int)blockIdx.x);
        pg8::EpiXM Ep{(pbf*)F.out, WSP(pbf, WS_XMC)};
        pg8::gemm_phase<pg8::EpiXM, pg8::StaticOrder, true, true>(F.lds, g, S, Ep);
    } SEAM(2);
    if (IN(3)) { p3_conv(F); } SEAM(3);
    if (IN(4)) { p3c_gates(F); } SEAM(4);
    if (IN(5)) { scan_phase(F, grid); } SEAM(5);
    if (IN(6)) { p5b_stats(F); } SEAM(6);
    if (IN(7)) {
        pg8::Gemm g{WSP(pbf, WS_HN2), WSP(pbf, WS_WZO), M_LAT, 4096, 1024, 1024, 1024, -1}; pg8::StaticOrder S; S.init(M_LAT, 4096, F.G, (int)blockIdx.x);
        pg8::EpiMix Ep{WSP(pbf, WS_Y), WSP(pbf, WS_H), (const pbf*)F.out, WSP(float, WS_ST), F.in[9], F.in[10], F.in[18], F.in[19]};
        pg8::gemm_phase<pg8::EpiMix, pg8::StaticOrder, true, true>(F.lds, g, S, Ep);
    } SEAM(7);
    if (IN(8)) {
        pg8::Gemm g{WSP(pbf, WS_Y), WSP(pbf, WS_WOA), M_LAT, 1024, 2048, 2048, 2048, -1}; pg8::StaticOrder S; S.init(M_LAT, 1024, F.G, (int)blockIdx.x);
        pg8::EpiF32 Ep{WSP(float, WS_YL), 1024};
        pg8::gemm_phase<pg8::EpiF32, pg8::StaticOrder, true, true>(F.lds, g, S, Ep);
    } SEAM(8);
    if (IN(9)) { p7b_rows(F); } SEAM(9);
    if (IN(10)) {
        pg8::Gemm g{WSP(pbf, WS_HN1), WSP(pbf, WS_WBIN), M_LAT, 4096, 1024, 1024, 1024, -1}; pg8::StaticOrder S; S.init(M_LAT, 4096, F.G, (int)blockIdx.x);
        pg8::EpiUZ Ep{WSP(pbf, WS_U), WSP(pbf, WS_Z1)};
        pg8::gemm_phase<pg8::EpiUZ, pg8::StaticOrder, true, true>(F.lds, g, S, Ep);
    } SEAM(10);
    if (IN(11)) { p9a_cols(F); } SEAM(11);
    if (IN(12)) { p9b_rows(F); } SEAM(12);
    if (IN(13)) {
        pg8::Gemm g{WSP(pbf, WS_U), WSP(pbf, WS_WPOOL), M_LAT, 2048, 512, 2048, 512, 1}; pg8::StaticOrder S; S.init(M_LAT, 2048, F.G, (int)blockIdx.x);
        pg8::EpiPool Ep{WSP(pbf, WS_Y1), WSP(pbf, WS_Z1), F.in[25]};
        pg8::gemm_phase<pg8::EpiPool, pg8::StaticOrder, true, true>(F.lds, g, S, Ep);
    } SEAM(13);
    if (IN(14)) {
        pg8::Gemm g{WSP(pbf, WS_Y1), WSP(pbf, WS_WBOUT), M_LAT, 1024, 2048, 2048, 2048, -1}; pg8::StaticOrder S; S.init(M_LAT, 1024, F.G, (int)blockIdx.x);
        pg8::EpiF32 Ep{WSP(float, WS_YL1), 1024};
        pg8::gemm_phase<pg8::EpiF32, pg8::StaticOrder, true, true>(F.lds, g, S, Ep);
    } SEAM(14);
    if (IN(15)) { p11b_rows(F); }
#undef IN
#undef SEAM
}

extern "C" void kernel_launch(void* const* d_in, const int* in_sizes, int n_in, void* d_out, int out_size, void* d_ws, size_t ws_size, hipStream_t stream) {
    static int grid = 0;
    if (grid == 0) {
        if (n_in != 27 || out_size != M_LAT * DM || ws_size < WS_END) { fprintf(stderr, "kernel_launch: unexpected problem (n_in %d, out %d, ws %zu); nothing launched\n", n_in, out_size, ws_size); grid = -1; return; }
        int dev = 0, cus = 0, per_cu = 0;
        if (hipGetDevice(&dev) != hipSuccess || hipDeviceGetAttribute(&cus, hipDeviceAttributeMultiprocessorCount, dev) != hipSuccess) { grid = -1; return; }
        if (hipFuncSetAttribute((const void*)mk_fwd, hipFuncAttributeMaxDynamicSharedMemorySize, LDS_BYTES) != hipSuccess) { fprintf(stderr, "kernel_launch: hipFuncSetAttribute failed\n"); grid = -1; return; }
        if (hipOccupancyMaxActiveBlocksPerMultiprocessor(&per_cu, (const void*)mk_fwd, NTHR, LDS_BYTES) != hipSuccess || per_cu < 1) { fprintf(stderr, "kernel_launch: occupancy query reports %d blocks per CU\n", per_cu); grid = -1; return; }
        if (cus != 256) { fprintf(stderr, "kernel_launch: built for 256 CUs, found %d\n", cus); grid = -1; return; }
        grid = cus;
    }
    if (grid < 0) return;
    Args a{};
    for (int i = 0; i < 27; ++i) a.in[i] = (const float*)d_in[i];
    a.out = (float*)d_out; a.ws = (unsigned char*)d_ws;
    void* kargs[] = {&a};
#if MK_N_LAUNCHES == 1
    a.ph_lo = 0; a.ph_hi = NPH;
    hipError_t e = hipLaunchCooperativeKernel((void*)mk_fwd, dim3(grid), dim3(NTHR), kargs, LDS_BYTES, stream);
    if (e != hipSuccess) fprintf(stderr, "kernel_launch: cooperative launch failed: %s\n", hipGetErrorString(e));
#else
    for (int p = 0; p < NPH; ++p) { a.ph_lo = p; a.ph_hi = p + 1;
        hipError_t e = hipLaunchCooperativeKernel((void*)mk_fwd, dim3(grid), dim3(NTHR), kargs, LDS_BYTES, stream);
        if (e != hipSuccess) { fprintf(stderr, "kernel_launch: launch %d failed: %s\n", p, hipGetErrorString(e)); break; } }
#endif
}
```

```cpp
#include <hip/hip_runtime.h>
#include <hip/hip_cooperative_groups.h>
#include <cstdio>
#include <cstdint>
namespace cg = cooperative_groups;

#define DI __device__ __forceinline__
#define LAS __attribute__((address_space(3)))
typedef unsigned short bf16;
typedef unsigned v4u __attribute__((ext_vector_type(4)));
typedef unsigned v2u __attribute__((ext_vector_type(2)));
typedef float f32x4 __attribute__((ext_vector_type(4)));
typedef float f32x2 __attribute__((ext_vector_type(2)));
typedef float f32x16 __attribute__((ext_vector_type(16)));
typedef short bf16x8 __attribute__((ext_vector_type(8)));
typedef __bf16 bf16x2_t __attribute__((ext_vector_type(2)));

constexpr int NB = 2, T = 8192, DM = 1024, E = 2048, NH = 4, DH = 512, TC = 256;
constexpr int M_LAT = NB * T, M_CTX = NB * TC, M_ALL = M_LAT + M_CTX;
constexpr int NCC = 264;
constexpr int NWAVES = 8, NTHR = 512;
constexpr float EPS = 1e-6f;

constexpr size_t MiB = 1u << 20, KiB = 1u << 10;
constexpr size_t WS_MOD = 128 * KiB;
constexpr size_t WS_GT = 256 * KiB;
constexpr size_t WS_MQ = 384 * KiB;
constexpr size_t WS_GC = 448 * KiB;
constexpr size_t WS_WXM = 2 * MiB, WS_WZO = 6 * MiB, WS_WOA = 14 * MiB;
constexpr size_t WS_XMC = 18 * MiB;
constexpr size_t WS_QA = 20 * MiB;
constexpr size_t WS_KA = 86 * MiB;
constexpr size_t WS_QK = 152 * MiB;
constexpr size_t WS_GP = 161 * MiB;
constexpr size_t WS_GS = 166 * MiB;
constexpr size_t WS_ST = 169 * MiB;
constexpr size_t WS_H = 170 * MiB;
constexpr size_t WS_HN = 170 * MiB;
constexpr size_t WS_WBIN = 234 * MiB, WS_WPOOL = 242 * MiB, WS_WBOUT = 244 * MiB;
constexpr size_t WS_HN2 = 20 * MiB;
constexpr size_t WS_Y = 86 * MiB;
constexpr size_t WS_YL = 20 * MiB;
constexpr size_t WS_HN1 = 152 * MiB;
constexpr size_t WS_U = 20 * MiB;
constexpr size_t WS_Z1 = 86 * MiB;
constexpr size_t WS_M1 = 152 * MiB;
constexpr size_t WS_Y1 = 152 * MiB;
constexpr size_t WS_YL1 = 20 * MiB;
constexpr size_t WS_END = 256 * MiB;

DI unsigned pk2(float lo, float hi) { f32x2 v = {lo, hi}; bf16x2_t b = __builtin_convertvector(v, bf16x2_t); return __builtin_bit_cast(unsigned, b); }
DI float bflo(unsigned u) { return __uint_as_float(u << 16); }
DI float bfhi(unsigned u) { return __uint_as_float(u & 0xffff0000u); }
DI float sigmoidf_(float x) { return __builtin_amdgcn_rcpf(1.f + __expf(-x)); }
DI float siluf_(float x) { return x * sigmoidf_(x); }
DI float wave_sum(float v) {
#pragma unroll
    for (int o = 1; o < 64; o <<= 1) v += __shfl_xor(v, o);
    return v;
}
namespace pg8 {
#define PG8_LAS __attribute__((address_space(3)))
typedef unsigned short bf16_t;
typedef short bf16x8 __attribute__((ext_vector_type(8)));
typedef float f32x4 __attribute__((ext_vector_type(4)));
typedef unsigned u32x4 __attribute__((ext_vector_type(4)));
constexpr int BM = 256, BK = 64, HALF = 128, HTB = HALF * BK * 2  , STAGE_BYTES = 8 * HTB, NXCD = 8, WGM = 8;

__host__ __device__ __forceinline__ int lds_byte(int r, int c) { const int st = (r >> 4) * 2 + (c >> 5), rr = r & 15, cc = c & 31, ob = rr * 64 + cc * 2; return st * 1024 + (ob ^ (((ob >> 9) & 1) << 5)); }
__host__ __device__ __forceinline__ void stage_rc(int b, int& R, int& C) { const int st = b / 1024, sb = b % 1024, swz = sb ^ (((sb >> 9) & 1) << 5); R = (st >> 1) * 16 + swz / 64; C = (st & 1) * 32 + (swz % 64) / 2; }
__host__ __device__ __forceinline__ int perm32(int rho) { const int n = rho >> 4, i = rho & 15; return 8 * (i >> 2) + 4 * n + (i & 3); }

struct Unit { int pm, pn; };
struct Gemm { const bf16_t* A; const bf16_t* Bt; int M, N, K, lda, ldb, agrp_shift;
    __device__ __forceinline__ size_t akoff(int pn) const { return agrp_shift >= 0 ? (size_t)(pn >> agrp_shift) * (size_t)K * 2 : (size_t)0; } };
struct StaticOrder {
    int nM, nN, nwg, G, c;
    __host__ __device__ void init(int M, int N, int G_, int c_) { nM = M / BM; nN = N / BM; nwg = nM * nN; G = G_; c = c_; }
    __host__ __device__ bool next(int i, Unit& u) const {
        const long L = (long)i * G + c; if (L >= nwg) return false;
        int wgid = (int)L; { const int q = nwg / NXCD, r = nwg % NXCD, xcd = wgid % NXCD, off = wgid / NXCD; wgid = (xcd < r ? xcd * (q + 1) : r * (q + 1) + (xcd - r) * q) + off; }
        const int nig = WGM * nN, gid = wgid / nig, fm = gid * WGM, gsz = (nM - fm) < WGM ? (nM - fm) : WGM;
        u.pm = fm + ((wgid % nig) % gsz); u.pn = (wgid % nig) / gsz; return true;
    }
    __device__ __forceinline__ void a_ready(const Unit&) const {}
    __device__ __forceinline__ void done(const Unit&) const {}
};
__device__ __forceinline__ unsigned pk2e(float lo, float hi) { return ::pk2(lo, hi); }
__device__ __forceinline__ float silu_e(float x) { return x * __builtin_amdgcn_rcpf(1.f + __expf(-x)); }
__device__ __forceinline__ float sigm_e(float x) { return __builtin_amdgcn_rcpf(1.f + __expf(-x)); }

struct EpiXM {
    static constexpr bool PERM = true, AFTER_DRAIN = false;
    bf16_t* Olat; bf16_t* Octx;
    __device__ __forceinline__ void operator()(const f32x4 (&acc)[2][2][4][2], const Unit& u, int wr, int wc, int fr, int fq) const {
        const int row0 = u.pm * BM + wr * 64 + fr, col0 = u.pn * BM + wc * 32 + 8 * fq;
        bf16_t* base = (u.pm < 64) ? Olat : Octx - (size_t)16384 * 2048;
#pragma unroll
        for (int ai = 0; ai < 2; ++ai)
#pragma unroll
            for (int m = 0; m < 4; ++m) { bf16_t* rowp = base + (size_t)(row0 + ai * HALF + m * 16) * 2048 + col0;
#pragma unroll
                for (int bj = 0; bj < 2; ++bj) { const f32x4 v0 = acc[ai][bj][m][0], v1 = acc[ai][bj][m][1];
                    u32x4 w; w.x = pk2e(v0[0], v0[1]); w.y = pk2e(v0[2], v0[3]); w.z = pk2e(v1[0], v1[1]); w.w = pk2e(v1[2], v1[3]);
                    *(u32x4*)(rowp + bj * HALF) = w; } }
    }
};
struct EpiUZ {
    static constexpr bool PERM = true, AFTER_DRAIN = false;
    bf16_t* U; bf16_t* Z1;
    __device__ __forceinline__ void operator()(const f32x4 (&acc)[2][2][4][2], const Unit& u, int wr, int wc, int fr, int fq) const {
        const int row0 = u.pm * BM + wr * 64 + fr; int colt = u.pn * BM; const bool isz = colt >= 2048; bf16_t* base = isz ? Z1 : U; if (isz) colt -= 2048;
        const int col0 = colt + wc * 32 + 8 * fq;
#pragma unroll
        for (int ai = 0; ai < 2; ++ai)
#pragma unroll
            for (int m = 0; m < 4; ++m) { bf16_t* rowp = base + (size_t)(row0 + ai * HALF + m * 16) * 2048 + col0;
#pragma unroll
                for (int bj = 0; bj < 2; ++bj) { f32x4 v0 = acc[ai][bj][m][0], v1 = acc[ai][bj][m][1];
                    if (isz) {
#pragma unroll
                        for (int e = 0; e < 4; ++e) { v0[e] = silu_e(v0[e]); v1[e] = silu_e(v1[e]); } }
                    u32x4 w; w.x = pk2e(v0[0], v0[1]); w.y = pk2e(v0[2], v0[3]); w.z = pk2e(v1[0], v1[1]); w.w = pk2e(v1[2], v1[3]);
                    *(u32x4*)(rowp + bj * HALF) = w; } }
    }
};
struct EpiF32 {
    static constexpr bool PERM = false, AFTER_DRAIN = false;
    float* O; int ldc;
    __device__ __forceinline__ void operator()(const f32x4 (&acc)[2][2][4][2], const Unit& u, int wr, int wc, int fr, int fq) const {
        const int row0 = u.pm * BM + wr * 64 + fr, col0 = u.pn * BM + wc * 32 + 4 * fq;
#pragma unroll
        for (int ai = 0; ai < 2; ++ai)
#pragma unroll
            for (int m = 0; m < 4; ++m) { float* rowp = O + (size_t)(row0 + ai * HALF + m * 16) * ldc + col0;
#pragma unroll
                for (int bj = 0; bj < 2; ++bj)
#pragma unroll
                    for (int n = 0; n < 2; ++n) *(f32x4*)(rowp + bj * HALF + n * 16) = acc[ai][bj][m][n]; }
    }
};
struct EpiPool {
    static constexpr bool PERM = true, AFTER_DRAIN = false;
    bf16_t* O; const bf16_t* Z1; const float* ps;
    __device__ __forceinline__ void operator()(const f32x4 (&acc)[2][2][4][2], const Unit& u, int wr, int wc, int fr, int fq) const {
        const int row0 = u.pm * BM + wr * 64 + fr, col0 = u.pn * BM + wc * 32 + 8 * fq;
        f32x4 sv[2][2];
#pragma unroll
        for (int bj = 0; bj < 2; ++bj)
#pragma unroll
            for (int n = 0; n < 2; ++n) sv[bj][n] = *(const f32x4*)(ps + col0 + bj * HALF + 4 * n);
#pragma unroll
        for (int ai = 0; ai < 2; ++ai)
#pragma unroll
            for (int m = 0; m < 4; ++m) { const size_t off = (size_t)(row0 + ai * HALF + m * 16) * 2048 + col0;
#pragma unroll
                for (int bj = 0; bj < 2; ++bj) { const u32x4 zz = *(const u32x4*)(Z1 + off + bj * HALF);
                    const f32x4 v0 = acc[ai][bj][m][0] * sv[bj][0], v1 = acc[ai][bj][m][1] * sv[bj][1];
                    u32x4 w; w.x = pk2e(v0[0] * ::bflo(zz.x), v0[1] * ::bfhi(zz.x)); w.y = pk2e(v0[2] * ::bflo(zz.y), v0[3] * ::bfhi(zz.y));
                    w.z = pk2e(v1[0] * ::bflo(zz.z), v1[1] * ::bfhi(zz.z)); w.w = pk2e(v1[2] * ::bflo(zz.w), v1[3] * ::bfhi(zz.w));
                    *(u32x4*)(O + off + bj * HALF) = w; } }
    }
};
struct EpiMix {
    static constexpr bool PERM = true, AFTER_DRAIN = false;
    bf16_t* Y; const bf16_t* Hs; const bf16_t* XM; const float* stats; const float* convw; const float* convb; const float* headn; const float* skip;
    __device__ __forceinline__ void operator()(const f32x4 (&acc)[2][2][4][2], const Unit& u, int wr, int wc, int fr, int fq) const {
        const int row0 = u.pm * BM + wr * 64 + fr, f0 = u.pn * HALF + wc * 32 + 8 * fq, head = f0 >> 9;
        float c0[8], c1[8], c2[8], cb[8], hw[8], sk[8];
#pragma unroll
        for (int q = 0; q < 2; ++q) { const f32x4 a = *(const f32x4*)(convw + f0 + 4 * q), b = *(const f32x4*)(convw + 2048 + f0 + 4 * q), c = *(const f32x4*)(convw + 4096 + f0 + 4 * q),
                d = *(const f32x4*)(convb + f0 + 4 * q), e = *(const f32x4*)(headn + f0 + 4 * q), f = *(const f32x4*)(skip + f0 + 4 * q);
#pragma unroll
            for (int i = 0; i < 4; ++i) { c0[4 * q + i] = a[i]; c1[4 * q + i] = b[i]; c2[4 * q + i] = c[i]; cb[4 * q + i] = d[i]; hw[4 * q + i] = e[i]; sk[4 * q + i] = f[i]; } }
#pragma unroll
        for (int ai = 0; ai < 2; ++ai)
#pragma unroll
            for (int m = 0; m < 4; ++m) {
                const int row = row0 + ai * HALF + m * 16, t = row & 8191; const size_t off = (size_t)row * 2048 + f0;
                const u32x4 hv = *(const u32x4*)(Hs + off), x1 = *(const u32x4*)(XM + off);
                u32x4 x0 = (u32x4){0u, 0u, 0u, 0u}, x2 = (u32x4){0u, 0u, 0u, 0u};
                if (t > 0) x0 = *(const u32x4*)(XM + off - 2048);
                if (t < 8191) x2 = *(const u32x4*)(XM + off + 2048);
                const float mean = stats[(size_t)row * 8 + head * 2], rstd = stats[(size_t)row * 8 + head * 2 + 1];
                float hh[8], a0[8], a1[8], a2[8];
                hh[0] = ::bflo(hv.x); hh[1] = ::bfhi(hv.x); hh[2] = ::bflo(hv.y); hh[3] = ::bfhi(hv.y); hh[4] = ::bflo(hv.z); hh[5] = ::bfhi(hv.z); hh[6] = ::bflo(hv.w); hh[7] = ::bfhi(hv.w);
                a0[0] = ::bflo(x0.x); a0[1] = ::bfhi(x0.x); a0[2] = ::bflo(x0.y); a0[3] = ::bfhi(x0.y); a0[4] = ::bflo(x0.z); a0[5] = ::bfhi(x0.z); a0[6] = ::bflo(x0.w); a0[7] = ::bfhi(x0.w);
                a1[0] = ::bflo(x1.x); a1[1] = ::bfhi(x1.x); a1[2] = ::bflo(x1.y); a1[3] = ::bfhi(x1.y); a1[4] = ::bflo(x1.z); a1[5] = ::bfhi(x1.z); a1[6] = ::bflo(x1.w); a1[7] = ::bfhi(x1.w);
                a2[0] = ::bflo(x2.x); a2[1] = ::bfhi(x2.x); a2[2] = ::bflo(x2.y); a2[3] = ::bfhi(x2.y); a2[4] = ::bflo(x2.z); a2[5] = ::bfhi(x2.z); a2[6] = ::bflo(x2.w); a2[7] = ::bfhi(x2.w);
                float y[8];
#pragma unroll
                for (int e = 0; e < 8; ++e) {
                    const float z = acc[ai][0][m][e >> 2][e & 3], og = acc[ai][1][m][e >> 2][e & 3];
                    const float cv = c0[e] * a0[e] + c1[e] * a1[e] + c2[e] * a2[e] + cb[e];
                    const float xc = silu_e(cv), hn = (hh[e] - mean) * rstd * hw[e];
                    y[e] = (sigm_e(og) * hn + sk[e] * xc) * silu_e(z);
                }
                u32x4 w; w.x = pk2e(y[0], y[1]); w.y = pk2e(y[2], y[3]); w.z = pk2e(y[4], y[5]); w.w = pk2e(y[6], y[7]);
                *(u32x4*)(Y + off) = w;
            }
    }
};

template <class Epi, class Sched, bool ALIGN_EPI = false, bool SP2 = false>
__device__ __forceinline__ void gemm_phase(PG8_LAS unsigned char* lds, const Gemm g, const Sched& S, const Epi& E) {
    const int tid = threadIdx.x, wid = __builtin_amdgcn_readfirstlane(tid >> 6), lane = tid & 63, wr = wid >> 2, wc = wid & 3, fr = lane & 15, fq = lane >> 4;
    const int K = g.K, nt = K / BK;
    unsigned voffA[2], voffB[2];
#pragma unroll
    for (int i = 0; i < 2; ++i) { int R, C; stage_rc(tid * 16 + i * 8192, R, C); const int Rb = Epi::PERM ? ((R & ~31) + perm32(R & 31)) : R;
        voffA[i] = (unsigned)(R * g.lda + C) * 2u; voffB[i] = (unsigned)(Rb * g.ldb + C) * 2u; }
    const size_t kstep = (size_t)(BK * 2);
    const size_t hstepA = (size_t)HALF * g.lda * 2, hstepB = (size_t)HALF * g.ldb * 2;
    const size_t tstepA = 2 * hstepA, tstepB = 2 * hstepB;
    const unsigned ldsw = (unsigned)wid * 1024u;
    const int aoff = lds_byte(wr * 64 + fr, fq * 8), boff = lds_byte(wc * 32 + fr, fq * 8);
#define PG8_SA(b, h) (((b) * 2 + (h)) * HTB)
#define PG8_SB(b, h) ((4 + (b) * 2 + (h)) * HTB)
#define PG8_STAGE(bufoff, gbase, voff) do { _Pragma("unroll") for (int _i = 0; _i < 2; ++_i) \
        __builtin_amdgcn_global_load_lds((const unsigned*)((const char*)(gbase) + (voff)[_i]), (PG8_LAS unsigned*)(lds + (bufoff) + ldsw + _i * 8192), 16, 0, 0); } while (0)
#define PG8_LDA(dst, b, h) do { _Pragma("unroll") for (int m = 0; m < 4; ++m) _Pragma("unroll") for (int k = 0; k < 2; ++k) dst[m][k] = *(const PG8_LAS bf16x8*)(lds + PG8_SA(b, h) + aoff + m * 2048 + k * 1024); } while (0)
#define PG8_LDB(dst, b, h) do { _Pragma("unroll") for (int n = 0; n < 2; ++n) _Pragma("unroll") for (int k = 0; k < 2; ++k) dst[n][k] = *(const PG8_LAS bf16x8*)(lds + PG8_SB(b, h) + boff + n * 2048 + k * 1024); } while (0)
#define PG8_MMA(ai, bj, At, Bt) do { __builtin_amdgcn_s_setprio(1); _Pragma("unroll") for (int m = 0; m < 4; ++m) _Pragma("unroll") for (int n = 0; n < 2; ++n) _Pragma("unroll") for (int k = 0; k < 2; ++k) \
        acc[ai][bj][m][n] = __builtin_amdgcn_mfma_f32_16x16x32_bf16(Bt[n][k], At[m][k], acc[ai][bj][m][n], 0, 0, 0); __builtin_amdgcn_s_setprio(0); } while (0)
#define PG8_WAIT_V(n) asm volatile("s_waitcnt vmcnt(" #n ")" ::: "memory")
#define PG8_WAIT_L(n) asm volatile("s_waitcnt lgkmcnt(" #n ")" ::: "memory")
#define PG8_BAR __builtin_amdgcn_s_barrier()
#define PG8_SCHED __builtin_amdgcn_sched_barrier(0)
    Unit cur, nxt; int ui = 0;
    if (!S.next(0, cur)) return;
    f32x4 acc[2][2][4][2];
#pragma unroll
    for (int a = 0; a < 2; ++a)
#pragma unroll
        for (int b = 0; b < 2; ++b)
#pragma unroll
            for (int m = 0; m < 4; ++m)
#pragma unroll
                for (int n = 0; n < 2; ++n) acc[a][b][m][n] = (f32x4){0.f, 0.f, 0.f, 0.f};
    bf16x8 At[4][2], B0[2][2], B1[2][2];
    const char* cA = (const char*)g.A + (size_t)cur.pm * tstepA + g.akoff(cur.pn); const char* cB = (const char*)g.Bt + (size_t)cur.pn * tstepB;
    S.a_ready(cur);
    if constexpr (SP2) {
        PG8_STAGE(PG8_SB(0, 0), cB, voffB); PG8_STAGE(PG8_SB(0, 1), cB + hstepB, voffB); PG8_STAGE(PG8_SA(0, 0), cA, voffA); PG8_STAGE(PG8_SA(0, 1), cA + hstepA, voffA);
        if (wr == 1) PG8_BAR;
        PG8_WAIT_V(2); PG8_BAR;
        PG8_STAGE(PG8_SB(1, 0), cB + kstep, voffB); PG8_STAGE(PG8_SA(1, 0), cA + kstep, voffA); PG8_STAGE(PG8_SB(1, 1), cB + hstepB + kstep, voffB);
        PG8_WAIT_V(6); PG8_BAR;
    } else {
        PG8_STAGE(PG8_SB(0, 0), cB, voffB); PG8_STAGE(PG8_SA(0, 0), cA, voffA); PG8_STAGE(PG8_SB(0, 1), cB + hstepB, voffB); PG8_STAGE(PG8_SA(0, 1), cA + hstepA, voffA);
        if (wr == 1) PG8_BAR;
        PG8_WAIT_V(4); PG8_BAR;
        PG8_STAGE(PG8_SB(1, 0), cB + kstep, voffB); PG8_STAGE(PG8_SA(1, 0), cA + kstep, voffA); PG8_STAGE(PG8_SB(1, 1), cB + hstepB + kstep, voffB);
        PG8_WAIT_V(6); PG8_BAR;
    }
    for (;;) {
        const bool has_next = S.next(ui + 1, nxt);
        const char* nA = has_next ? (const char*)g.A + (size_t)nxt.pm * tstepA + g.akoff(nxt.pn) : cA; const char* nB = has_next ? (const char*)g.Bt + (size_t)nxt.pn * tstepB : cB;
        for (int t = 0; t < nt; t += 2) {
            const bool last = (t == nt - 2);
            const char* a1 = cA + (size_t)(t + 1) * kstep;
            const char* a2 = last ? nA : cA + (size_t)(t + 2) * kstep; const char* b2 = last ? nB : cB + (size_t)(t + 2) * kstep;
            const char* a3 = a2 + kstep; const char* b3 = b2 + kstep;
            if (last && has_next) S.a_ready(nxt);
            if constexpr (SP2) {
            PG8_LDB(B0, 0, 0); PG8_LDB(B1, 0, 1); PG8_SCHED; PG8_LDA(At, 0, 0); PG8_STAGE(PG8_SA(1, 1), a1 + hstepA, voffA);
            PG8_WAIT_V(8); PG8_WAIT_L(0); PG8_BAR; PG8_MMA(0, 0, At, B0); PG8_MMA(0, 1, At, B1); PG8_BAR; PG8_SCHED;
            PG8_LDA(At, 0, 1); PG8_STAGE(PG8_SB(0, 0), b2, voffB); PG8_STAGE(PG8_SB(0, 1), b2 + hstepB, voffB); PG8_STAGE(PG8_SA(0, 0), a2, voffA);
            PG8_WAIT_V(8); PG8_WAIT_L(0); PG8_BAR; PG8_MMA(1, 0, At, B0); PG8_MMA(1, 1, At, B1); PG8_BAR; PG8_SCHED;
            PG8_LDB(B0, 1, 0); PG8_LDB(B1, 1, 1); PG8_SCHED; PG8_LDA(At, 1, 0); PG8_STAGE(PG8_SA(0, 1), a2 + hstepA, voffA);
            PG8_WAIT_V(8); PG8_WAIT_L(0); PG8_BAR; PG8_MMA(0, 0, At, B0); PG8_MMA(0, 1, At, B1); PG8_BAR; PG8_SCHED;
            PG8_LDA(At, 1, 1); PG8_STAGE(PG8_SB(1, 0), b3, voffB); PG8_STAGE(PG8_SB(1, 1), b3 + hstepB, voffB); PG8_STAGE(PG8_SA(1, 0), a3, voffA);
            PG8_WAIT_V(8); PG8_WAIT_L(0); PG8_BAR; PG8_MMA(1, 0, At, B0); PG8_MMA(1, 1, At, B1); PG8_BAR; PG8_SCHED;
            } else {
            PG8_LDB(B0, 0, 0); PG8_SCHED; PG8_LDA(At, 0, 0); PG8_STAGE(PG8_SA(1, 1), a1 + hstepA, voffA);
            PG8_WAIT_L(8); PG8_BAR; PG8_WAIT_L(0); PG8_MMA(0, 0, At, B0); PG8_BAR; PG8_SCHED;
            PG8_LDB(B1, 0, 1); PG8_STAGE(PG8_SB(0, 0), b2, voffB);
            PG8_BAR; PG8_WAIT_L(0); PG8_MMA(0, 1, At, B1); PG8_BAR;
            PG8_LDA(At, 0, 1); PG8_STAGE(PG8_SA(0, 0), a2, voffA);
            PG8_BAR; PG8_WAIT_L(0); PG8_MMA(1, 0, At, B0); PG8_BAR; PG8_SCHED;
            PG8_STAGE(PG8_SB(0, 1), b2 + hstepB, voffB);
            PG8_WAIT_V(6); PG8_BAR; PG8_MMA(1, 1, At, B1); PG8_BAR;
            PG8_LDB(B0, 1, 0); PG8_SCHED; PG8_LDA(At, 1, 0); PG8_STAGE(PG8_SA(0, 1), a2 + hstepA, voffA);
            PG8_WAIT_L(8); PG8_BAR; PG8_WAIT_L(0); PG8_MMA(0, 0, At, B0); PG8_BAR; PG8_SCHED;
            PG8_LDB(B1, 1, 1); PG8_STAGE(PG8_SB(1, 0), b3, voffB);
            PG8_BAR; PG8_WAIT_L(0); PG8_MMA(0, 1, At, B1); PG8_BAR;
            PG8_LDA(At, 1, 1); PG8_STAGE(PG8_SA(1, 0), a3, voffA);
            PG8_BAR; PG8_WAIT_L(0); PG8_MMA(1, 0, At, B0); PG8_BAR; PG8_SCHED;
            PG8_STAGE(PG8_SB(1, 1), b3 + hstepB, voffB);
            PG8_WAIT_V(6); PG8_BAR; PG8_MMA(1, 1, At, B1); PG8_BAR;
            }
        }
        if constexpr (ALIGN_EPI) { if (wr == 0) PG8_BAR; }
        if constexpr (!Epi::AFTER_DRAIN) { E(acc, cur, wr, wc, fr, fq); S.done(cur); }
        if (!has_next) break;
#pragma unroll
        for (int a = 0; a < 2; ++a)
#pragma unroll
            for (int b = 0; b < 2; ++b)
#pragma unroll
                for (int m = 0; m < 4; ++m)
#pragma unroll
                    for (int n = 0; n < 2; ++n) acc[a][b][m][n] = (f32x4){0.f, 0.f, 0.f, 0.f};
        cur = nxt; cA = nA; cB = nB; ++ui;
        if constexpr (ALIGN_EPI) { if (wr == 1) PG8_BAR; }
    }
    PG8_WAIT_V(0);
    if constexpr (!ALIGN_EPI) { if (wr == 0) PG8_BAR; }
    PG8_BAR;
    if constexpr (Epi::AFTER_DRAIN) { E.fused(acc, cur, wr, wc, fr, fq, lds, wid, lane); S.done(cur); }
#undef PG8_SA
#undef PG8_SB
#undef PG8_STAGE
#undef PG8_LDA
#undef PG8_LDB
#undef PG8_MMA
#undef PG8_WAIT_V
#undef PG8_WAIT_L
#undef PG8_BAR
#undef PG8_SCHED
}
}
#define GAS __attribute__((address_space(1)))
#define XB_TMO      128
#define XB_XCNT(j)  (256  + 64 * (j))
#define XB_XSUB(j)  (1280 + 64 * (j))
#define XB_XGEN(j)  (2304 + 64 * (j))
#define XB_TOP      3328
#define XB_TOPGEN   3392
#define XCD_BAR_WORDS 3456
#define XB_SPIN_CAP (1u << 18)

__device__ __forceinline__ unsigned xb_ld(unsigned* p)              { return __hip_atomic_load(p, __ATOMIC_RELAXED, __HIP_MEMORY_SCOPE_AGENT); }
__device__ __forceinline__ unsigned xb_add(unsigned* p, unsigned v) { return __hip_atomic_fetch_add(p, v, __ATOMIC_RELAXED, __HIP_MEMORY_SCOPE_AGENT); }
__device__ __forceinline__ unsigned xb_xcc_id() { return (unsigned)__builtin_amdgcn_s_getreg((3 << 11) | 20) & 0xFu; }
#define XB_SPIN(cond, bar) do { unsigned _sp = 0; while (cond) { __builtin_amdgcn_s_sleep(1); \
    if ((++_sp & 255u) == 0u) { if (xb_ld(&(bar)[XB_TMO])) break; if (_sp > XB_SPIN_CAP) { atomicAdd(&(bar)[XB_TMO], 1u); break; } } } } while (0)

struct XcdBarrier {
    unsigned* bar; unsigned x;
    volatile LAS unsigned* st;
};

__device__ __forceinline__ XcdBarrier xcd_barrier_post(unsigned* bar, volatile LAS unsigned* st) {
    XcdBarrier b; b.bar = bar; b.x = xb_xcc_id(); b.st = st;
    if (threadIdx.x == 0) (void)xb_add(&bar[XB_XCNT(b.x)], 1u);
    return b;
}
__device__ __forceinline__ void xcd_barrier_complete(unsigned* bar, unsigned x, unsigned& nloc, unsigned& nx) {
    const unsigned G = gridDim.x * gridDim.y * gridDim.z;
    unsigned sum, cnt, mine, sp = 0u;
    for (;;) {
        sum = 0u; cnt = 0u; mine = 0u;
#pragma unroll
        for (unsigned j = 0; j < 16; ++j) { const unsigned c = xb_ld(&bar[XB_XCNT(j)]); sum += c; cnt += (c > 0u) ? 1u : 0u; mine = (j == x) ? c : mine; }
        if (sum == G) break;
        __builtin_amdgcn_s_sleep(1);
        if ((++sp & 255u) == 0u) { if (xb_ld(&bar[XB_TMO])) break; if (sp > XB_SPIN_CAP) { atomicAdd(&bar[XB_TMO], 1u); break; } }
    }
    nloc = mine > 0u ? mine : 1u; nx = cnt > 0u ? cnt : 1u;
}

__device__ __forceinline__ void xcd_barrier(const XcdBarrier& b) {
    asm volatile("s_waitcnt vmcnt(0)" ::: "memory");
    __syncthreads();
    if (threadIdx.x == 0) {
        unsigned* bar = b.bar;
        __builtin_amdgcn_s_waitcnt(0);
        unsigned nloc = b.st[0], nx = b.st[1];
        if (nloc == 0u) { xcd_barrier_complete(bar, b.x, nloc, nx); b.st[0] = nloc; b.st[1] = nx; }
        const unsigned old = xb_add(&bar[XB_XSUB(b.x)], 1u);
        const unsigned gen = old / nloc;
        if (old + 1u == (gen + 1u) * nloc) {
            __builtin_amdgcn_fence(__ATOMIC_RELEASE, "agent");
            asm volatile("s_waitcnt vmcnt(0)" ::: "memory");
            const unsigned og = xb_add(&bar[XB_TOP], 1u);
            const unsigned tg = og / nx;
            if (og + 1u == (tg + 1u) * nx) xb_add(&bar[XB_TOPGEN], 1u);
            else XB_SPIN(xb_ld(&bar[XB_TOPGEN]) == tg, bar);
            __builtin_amdgcn_fence(__ATOMIC_ACQUIRE, "agent");
            xb_add(&bar[XB_XGEN(b.x)], 1u);
            asm volatile("s_waitcnt vmcnt(0)" ::: "memory");
        } else {
            XB_SPIN(xb_ld(&bar[XB_XGEN(b.x)]) == gen, bar);
            __builtin_amdgcn_fence(__ATOMIC_ACQUIRE, "agent");
            asm volatile("s_waitcnt vmcnt(0)" ::: "memory");
        }
    }
    __syncthreads();
}
#ifndef MK_N_LAUNCHES
#define MK_N_LAUNCHES 1
#endif
constexpr int NPH = 16;
constexpr int LDS_BYTES = 147456;

struct Args { const float* in[27]; float* out; unsigned char* ws; int ph_lo, ph_hi; };

struct Frame {
    LAS unsigned char* lds;
    int tid, lane, wave, vcu, G;
    const float* const* in;
    float* out; unsigned char* ws;
};
#define WSP(T_, off) ((T_*)(F.ws + (off)))
#define MFMA32(a, b, c) __builtin_amdgcn_mfma_f32_32x32x16_bf16((a), (b), (c), 0, 0, 0)
#define MFMA16(a, b, c) __builtin_amdgcn_mfma_f32_16x16x32_bf16((a), (b), (c), 0, 0, 0)

DI void tr_item(const float* W, int ldw, int k0, int scol0, bf16* WT, int K, int drow0, LAS float* scr, int lane) {
#pragma unroll 8
    for (int i = 0; i < 32; ++i) { const int kk = 2 * i + (lane >> 5); scr[kk * 33 + (lane & 31)] = W[(size_t)(k0 + kk) * ldw + scol0 + (lane & 31)]; }
    asm volatile("s_waitcnt lgkmcnt(0)" ::: "memory");
    const int c = lane & 7;
#pragma unroll
    for (int j = 0; j < 4; ++j) { const int n = (lane >> 3) + 8 * j; const LAS float* s = scr + (8 * c) * 33 + n;
        v4u o; o.x = pk2(s[0 * 33], s[1 * 33]); o.y = pk2(s[2 * 33], s[3 * 33]); o.z = pk2(s[4 * 33], s[5 * 33]); o.w = pk2(s[6 * 33], s[7 * 33]);
        *(v4u*)(WT + (size_t)(drow0 + n) * K + k0 + 8 * c) = o; }
    asm volatile("s_waitcnt lgkmcnt(0)" ::: "memory");
}
DI void p0_prologue(Frame& F) {
    if (F.vcu < 96) {
        const int l = F.vcu / 48, cb = F.vcu % 48, j = cb * 64 + F.lane;
        LAS float* sc = (LAS float*)F.lds;
        const float* c = F.in[1]; const float* cctx = F.in[3];
        for (int i = F.tid; i < 3072; i += NTHR) { const float v = i < 2048 ? c[i] : cctx[i - 2048]; sc[i] = v / (1.f + expf(-v)); }
        __syncthreads();
        const float* wa = F.in[4] + (size_t)l * 1024 * 3072;
        float s0 = 0.f, s1 = 0.f, s2 = 0.f;
#pragma unroll 8
        for (int kk = 0; kk < 128; ++kk) { const int k = F.wave * 128 + kk; const float wv = wa[(size_t)k * 3072 + j]; s0 += sc[k] * wv; s1 += sc[1024 + k] * wv; s2 += sc[2048 + k] * wv; }
        LAS float* pp = sc + 3072;
        pp[(F.wave * 3 + 0) * 64 + F.lane] = s0; pp[(F.wave * 3 + 1) * 64 + F.lane] = s1; pp[(F.wave * 3 + 2) * 64 + F.lane] = s2;
        __syncthreads();
        if (F.tid < 192) { const int cd = F.tid >> 6, ln = F.tid & 63; float s = 0.f;
#pragma unroll
            for (int w = 0; w < 8; ++w) s += pp[(w * 3 + cd) * 64 + ln];
            WSP(float, WS_MOD)[(l * 3 + cd) * 3072 + cb * 64 + ln] = s + F.in[5][l * 3072 + cb * 64 + ln]; }
        __syncthreads();
    } else if (F.vcu < 128) {
        const float* wq = F.in[11]; const float* wk = F.in[12]; const float* wvv = F.in[13];
        const float sK = 0.044194173824159216f;
        for (int idx = (F.vcu - 96) * NTHR + F.tid; idx < 4 * 16 * 1024; idx += 32 * NTHR) {
            const int k = idx & 1023, j16 = (idx >> 10) & 15, h = idx >> 14, dir = j16 >> 3, jj = j16 & 7;
            const float* wg = dir ? F.in[16] : F.in[14];
            const int f = h * 512 + (k & 511), g = f >> 2, i = f & 3; float s = 0.f;
            if (k < 512) {
#pragma unroll
                for (int o = 0; o < 4; ++o) s += wq[g * 16 + i * 4 + o] * wg[(size_t)(4 * g + o) * 8 + jj] + sK * wk[g * 16 + i * 4 + o] * wg[(size_t)(2048 + 4 * g + o) * 8 + jj];
            } else {
#pragma unroll
                for (int o = 0; o < 4; ++o) s += wvv[g * 16 + i * 4 + o] * wg[(size_t)(4096 + 4 * g + o) * 8 + jj];
            }
            WSP(bf16, WS_GT)[idx] = (bf16)(pk2(s, 0.f) & 0xffffu);
        }
        for (int idx = (F.vcu - 96) * NTHR + F.tid; idx < 512 * 16; idx += 32 * NTHR) {
            const int g = idx >> 4, i = (idx >> 2) & 3, i2 = idx & 3; float s = 0.f;
#pragma unroll
            for (int o = 0; o < 4; ++o) s += wq[g * 16 + i * 4 + o] * wk[g * 16 + i2 * 4 + o];
            WSP(float, WS_MQ)[idx] = s * sK;
        }
    }
    LAS float* scr = (LAS float*)(F.lds + 32768 + F.wave * 12288);
    const int gw = F.vcu * NWAVES + F.wave, NGW = F.G * NWAVES;
    constexpr int I_XM = 16 * 64, I_ZO = 16 * 128, I_OA = 32 * 32, I_BIN = 16 * 128, I_POOL = 4 * 8 * 16, I_BOUT = 32 * 32;
    constexpr int NITEMS = I_XM + I_ZO + I_OA + I_BIN + I_POOL + I_BOUT;
    for (int it = gw; it < NITEMS; it += NGW) {
        int r = it;
        if (r < I_XM) { const int kb = r / 64, nb = r % 64; tr_item(F.in[8], 6144, 64 * kb, 32 * nb, WSP(bf16, WS_WXM), 1024, 32 * nb, scr, F.lane); continue; } r -= I_XM;
        if (r < I_ZO) { const int kb = r / 128, nb = r % 128, d0 = 32 * nb, j = d0 >> 8, win = d0 & 255; const int sc0 = (win < 128 ? 2048 : 4096 - 128) + 128 * j + win;
            tr_item(F.in[8], 6144, 64 * kb, sc0, WSP(bf16, WS_WZO), 1024, d0, scr, F.lane); continue; } r -= I_ZO;
        if (r < I_OA) { const int kb = r / 32, nb = r % 32; tr_item(F.in[20], 1024, 64 * kb, 32 * nb, WSP(bf16, WS_WOA), 2048, 32 * nb, scr, F.lane); continue; } r -= I_OA;
        if (r < I_BIN) { const int kb = r / 128, nb = r % 128; tr_item(F.in[23], 4096, 64 * kb, 32 * nb, WSP(bf16, WS_WBIN), 1024, 32 * nb, scr, F.lane); continue; } r -= I_BIN;
        if (r < I_POOL) { const int g = r / 128, q = r % 128, kb = q / 16, nb = q % 16; tr_item(F.in[24] + (size_t)g * 512 * 512, 512, 64 * kb, 32 * nb, WSP(bf16, WS_WPOOL), 512, 512 * g + 32 * nb, scr, F.lane); continue; } r -= I_POOL;
        { const int kb = r / 32, nb = r % 32; tr_item(F.in[26], 1024, 64 * kb, 32 * nb, WSP(bf16, WS_WBOUT), 2048, 32 * nb, scr, F.lane); }
    }
}

DI void modnorm_row(const float* xrow, const float* g, const float* mod, bf16* orow, int lane) {
    f32x4 v[4]; float ss = 0.f;
#pragma unroll
    for (int j = 0; j < 4; ++j) { v[j] = *(const f32x4*)(xrow + 256 * j + 4 * lane); ss += v[j][0] * v[j][0] + v[j][1] * v[j][1] + v[j][2] * v[j][2] + v[j][3] * v[j][3]; }
    const float rstd = 1.f / sqrtf(wave_sum(ss) * (1.f / 1024.f) + EPS);
#pragma unroll
    for (int j = 0; j < 4; ++j) { const int c = 256 * j + 4 * lane; const f32x4 gg = *(const f32x4*)(g + c), sh = *(const f32x4*)(mod + c), sc = *(const f32x4*)(mod + 1024 + c);
        const f32x4 y = v[j] * rstd * gg * (sc + 1.f) + sh; v2u o; o.x = pk2(y[0], y[1]); o.y = pk2(y[2], y[3]); *(v2u*)(orow + c) = o; }
}
DI void p1_hn(Frame& F, bf16* HN, int nrows) {
    const int gw = F.vcu * NWAVES + F.wave, NGW = F.G * NWAVES; const float* mod0 = WSP(float, WS_MOD);
    for (int m = gw; m < nrows; m += NGW) {
        const float* xr = m < M_LAT ? F.in[0] + (size_t)m * 1024 : F.in[2] + (size_t)(m - M_LAT) * 1024;
        const float* mod = mod0 + (m < M_LAT ? (m >> 13) : 2) * 3072;
        modnorm_row(xr, F.in[6], mod, HN + (size_t)m * 1024, F.lane);
    }
}
DI void p7b_rows(Frame& F) {
    const int gw = F.vcu * NWAVES + F.wave, NGW = F.G * NWAVES, lane = F.lane; const float* mod0 = WSP(float, WS_MOD);
    const float* YL = WSP(float, WS_YL); bf16* HN1 = WSP(bf16, WS_HN1);
    for (int m = gw; m < M_LAT; m += NGW) {
        const float* yr = YL + (size_t)m * 1024; const float* xr = F.in[0] + (size_t)m * 1024; const int bb = m >> 13;
        const float* md0 = mod0 + bb * 3072; const float* md1 = mod0 + (3 + bb) * 3072;
        f32x4 v[4]; float ss = 0.f;
#pragma unroll
        for (int j = 0; j < 4; ++j) { v[j] = *(const f32x4*)(yr + 256 * j + 4 * lane); ss += v[j][0] * v[j][0] + v[j][1] * v[j][1] + v[j][2] * v[j][2] + v[j][3] * v[j][3]; }
        const float rstd = 1.f / sqrtf(wave_sum(ss) * (1.f / 1024.f) + EPS); float s1 = 0.f;
#pragma unroll
        for (int j = 0; j < 4; ++j) { const int c = 256 * j + 4 * lane; const f32x4 pg = *(const f32x4*)(F.in[7] + c), gt = *(const f32x4*)(md0 + 2048 + c), xx = *(const f32x4*)(xr + c);
            v[j] = xx + gt * (v[j] * rstd * pg); *(f32x4*)(F.out + (size_t)m * 1024 + c) = v[j];
            s1 += v[j][0] * v[j][0] + v[j][1] * v[j][1] + v[j][2] * v[j][2] + v[j][3] * v[j][3]; }
        const float r1 = 1.f / sqrtf(wave_sum(s1) * (1.f / 1024.f) + EPS);
#pragma unroll
        for (int j = 0; j < 4; ++j) { const int c = 256 * j + 4 * lane; const f32x4 gg = *(const f32x4*)(F.in[21] + c), sh = *(const f32x4*)(md1 + c), sc = *(const f32x4*)(md1 + 1024 + c);
            const f32x4 y = v[j] * r1 * gg * (sc + 1.f) + sh; v2u o; o.x = pk2(y[0], y[1]); o.y = pk2(y[2], y[3]); *(v2u*)(HN1 + (size_t)m * 1024 + c) = o; }
    }
}
DI void p11b_rows(Frame& F) {
    const int gw = F.vcu * NWAVES + F.wave, NGW = F.G * NWAVES, lane = F.lane; const float* mod0 = WSP(float, WS_MOD);
    const float* YL = WSP(float, WS_YL1);
    for (int m = gw; m < M_LAT; m += NGW) {
        const float* yr = YL + (size_t)m * 1024; const float* md1 = mod0 + (3 + (m >> 13)) * 3072;
        f32x4 v[4]; float ss = 0.f;
#pragma unroll
        for (int j = 0; j < 4; ++j) { v[j] = *(const f32x4*)(yr + 256 * j + 4 * lane); ss += v[j][0] * v[j][0] + v[j][1] * v[j][1] + v[j][2] * v[j][2] + v[j][3] * v[j][3]; }
        const float rstd = 1.f / sqrtf(wave_sum(ss) * (1.f / 1024.f) + EPS);
#pragma unroll
        for (int j = 0; j < 4; ++j) { const int c = 256 * j + 4 * lane; const f32x4 pg = *(const f32x4*)(F.in[22] + c), gt = *(const f32x4*)(md1 + 2048 + c);
            float* op = F.out + (size_t)m * 1024 + c; const f32x4 xx = *(const f32x4*)op; *(f32x4*)op = xx + gt * (v[j] * rstd * pg); }
    }
}
DI void p5b_stats(Frame& F) {
    const int gw = F.vcu * NWAVES + F.wave, NGW = F.G * NWAVES, lane = F.lane;
    const bf16* Hs = WSP(bf16, WS_H); float* st = WSP(float, WS_ST);
    for (int it = gw; it < M_LAT * 4; it += NGW) {
        const int row = it >> 2, h = it & 3; const v4u hv = *(const v4u*)(Hs + (size_t)row * 2048 + h * 512 + 8 * lane);
        float x[8] = {bflo(hv.x), bfhi(hv.x), bflo(hv.y), bfhi(hv.y), bflo(hv.z), bfhi(hv.z), bflo(hv.w), bfhi(hv.w)};
        float s = 0.f;
#pragma unroll
        for (int i = 0; i < 8; ++i) s += x[i];
        const float mean = wave_sum(s) * (1.f / 512.f); float q = 0.f;
#pragma unroll
        for (int i = 0; i < 8; ++i) { const float d = x[i] - mean; q += d * d; }
        const float rstd = 1.f / sqrtf(wave_sum(q) * (1.f / 512.f) + EPS);
        if (lane == 0) { st[(size_t)row * 8 + 2 * h] = mean; st[(size_t)row * 8 + 2 * h + 1] = rstd; }
    }
    p1_hn(F, WSP(bf16, WS_HN2), M_LAT);
}

DI void p3_conv(Frame& F) {
    const int w = F.wave, lane = F.lane, fr = lane & 15, fq = lane >> 4;
    LAS unsigned char* XCs = F.lds; LAS unsigned char* Qs = F.lds + 33792; LAS unsigned char* XMs = F.lds + 67584; LAS float* QKs = (LAS float*)F.lds;
    const float* convw = F.in[9]; const float* convb = F.in[10]; const float* MQ = WSP(float, WS_MQ); const bf16* GT = WSP(bf16, WS_GT);
    for (int tile = F.vcu; tile < NCC * 4; tile += F.G) {
        const int cc = tile >> 2, h = tile & 3; const bool lat = cc < 256;
        const int cloc = lat ? (cc & 127) : ((cc - 256) & 3), clast = lat ? 127 : 3;
        const int rowbase = lat ? ((cc >> 7) * 8192 + cloc * 64) : (((cc - 256) >> 2) * 256 + cloc * 64);
        const bf16* XMb = lat ? (const bf16*)F.out : WSP(bf16, WS_XMC);
        const int grow0 = lat ? rowbase : M_LAT + rowbase;
        bf16* QAt = WSP(bf16, WS_QA) + (size_t)tile * 32768; bf16* KAt = WSP(bf16, WS_KA) + (size_t)tile * 32768;
        f32x4 qk0 = {0.f, 0.f, 0.f, 0.f}, qk1 = {0.f, 0.f, 0.f, 0.f}, ga = {0.f, 0.f, 0.f, 0.f};
#pragma unroll 1
        for (int half = 0; half < 2; ++half) {
            const int fl = half * 256 + 4 * lane, f = h * 512 + fl;
            const f32x4 cw0 = *(const f32x4*)(convw + f), cw1 = *(const f32x4*)(convw + 2048 + f), cw2 = *(const f32x4*)(convw + 4096 + f), cbv = *(const f32x4*)(convb + f);
            f32x4 mq[4];
#pragma unroll
            for (int i = 0; i < 4; ++i) mq[i] = *(const f32x4*)(MQ + (f >> 2) * 16 + 4 * i);
            v2u xr[10];
#pragma unroll
            for (int i = 0; i < 10; ++i) { const int r = 8 * w - 1 + i; const bool ok = (r >= 0 || cloc > 0) && (r < 64 || cloc < clast);
                xr[i] = (v2u){0u, 0u}; if (ok) xr[i] = *(const v2u*)(XMb + (size_t)(rowbase + r) * 2048 + f); }
            unsigned ka[4][4], tmp[4] = {0u, 0u, 0u, 0u};
            const int wq_ = fl >> 6, ksq = (fl >> 4) & 3, r16 = fl & 15, hq = (r16 >> 2) & 1, jg = r16 >> 3;
#pragma unroll
            for (int tt = 0; tt < 8; ++tt) {
                const float x0[4] = {bflo(xr[tt].x), bfhi(xr[tt].x), bflo(xr[tt].y), bfhi(xr[tt].y)};
                const float x1[4] = {bflo(xr[tt + 1].x), bfhi(xr[tt + 1].x), bflo(xr[tt + 1].y), bfhi(xr[tt + 1].y)};
                const float x2[4] = {bflo(xr[tt + 2].x), bfhi(xr[tt + 2].x), bflo(xr[tt + 2].y), bfhi(xr[tt + 2].y)};
                float xc[4];
#pragma unroll
                for (int o = 0; o < 4; ++o) xc[o] = siluf_(cw0[o] * x0[o] + cw1[o] * x1[o] + cw2[o] * x2[o] + cbv[o]);
                float qt[4];
#pragma unroll
                for (int i2 = 0; i2 < 4; ++i2) qt[i2] = xc[0] * mq[0][i2] + xc[1] * mq[1][i2] + xc[2] * mq[2][i2] + xc[3] * mq[3][i2];
                const v2u xcb = (v2u){pk2(xc[0], xc[1]), pk2(xc[2], xc[3])}, qb = (v2u){pk2(qt[0], qt[1]), pk2(qt[2], qt[3])};
                const int t = 8 * w + tt; const int lo = (t * 264 + 4 * lane) * 2;
                *(LAS v2u*)(XCs + lo) = xcb; *(LAS v2u*)(Qs + lo) = qb; *(LAS v2u*)(XMs + lo) = xr[tt + 1];
                *(v2u*)(QAt + ((((wq_ * 2 + (t >> 5)) * 4 + ksq) * 64 + (t & 31) + 32 * hq) * 8 + jg * 4)) = qb;
                const unsigned b0 = xcb.x & 0xffffu, b1 = xcb.x >> 16, b2 = xcb.y & 0xffffu, b3 = xcb.y >> 16;
                if ((tt & 1) == 0) { tmp[0] = b0; tmp[1] = b1; tmp[2] = b2; tmp[3] = b3; }
                else { ka[0][tt >> 1] = tmp[0] | (b0 << 16); ka[1][tt >> 1] = tmp[1] | (b1 << 16); ka[2][tt >> 1] = tmp[2] | (b2 << 16); ka[3][tt >> 1] = tmp[3] | (b3 << 16); }
            }
#pragma unroll
            for (int o = 0; o < 4; ++o) { const int d = fl + o; *(v4u*)(KAt + ((((d >> 5) * 4 + (w >> 1)) * 64 + (d & 31) + 32 * (w & 1)) * 8)) = (v4u){ka[o][0], ka[o][1], ka[o][2], ka[o][3]}; }
            __syncthreads();
            const int mt_ = w >> 1, nt0 = 2 * (w & 1);
#pragma unroll
            for (int ks = 0; ks < 8; ++ks) {
                const bf16x8 a = *(const LAS bf16x8*)(Qs + ((16 * mt_ + fr) * 264 + 32 * ks + 8 * fq) * 2);
                const bf16x8 b0 = *(const LAS bf16x8*)(XCs + ((16 * nt0 + fr) * 264 + 32 * ks + 8 * fq) * 2);
                const bf16x8 b1 = *(const LAS bf16x8*)(XCs + ((16 * (nt0 + 1) + fr) * 264 + 32 * ks + 8 * fq) * 2);
                qk0 = MFMA16(a, b0, qk0); qk1 = MFMA16(a, b1, qk1);
            }
            if (w < 4) {
#pragma unroll
                for (int ks = 0; ks < 8; ++ks) {
                    const bf16x8 a1 = *(const LAS bf16x8*)(XCs + ((16 * w + fr) * 264 + 32 * ks + 8 * fq) * 2);
                    const bf16x8 a2 = *(const LAS bf16x8*)(XMs + ((16 * w + fr) * 264 + 32 * ks + 8 * fq) * 2);
                    const bf16x8 g1 = *(const bf16x8*)(GT + ((h * 16 + fr) * 1024 + half * 256 + 32 * ks + 8 * fq));
                    const bf16x8 g2 = *(const bf16x8*)(GT + ((h * 16 + fr) * 1024 + 512 + half * 256 + 32 * ks + 8 * fq));
                    ga = MFMA16(a1, g1, ga); ga = MFMA16(a2, g2, ga);
                }
            }
            __syncthreads();
        }
        {   const int mt_ = w >> 1, nt0 = 2 * (w & 1);
#pragma unroll
            for (int r = 0; r < 4; ++r) { QKs[(16 * mt_ + 4 * fq + r) * 65 + 16 * nt0 + fr] = qk0[r]; QKs[(16 * mt_ + 4 * fq + r) * 65 + 16 * (nt0 + 1) + fr] = qk1[r]; }
            if (w < 4) { float* GP = WSP(float, WS_GP) + ((size_t)h * M_ALL + grow0 + 16 * w + 4 * fq) * 16 + fr;
#pragma unroll
                for (int r = 0; r < 4; ++r) GP[r * 16] = ga[r]; }
        }
        __syncthreads();
        {   const int t = 32 * (w >> 2) + (lane & 31), s0 = 16 * (w & 3) + 8 * (lane >> 5); const LAS float* q = QKs + t * 65 + s0;
            *(v4u*)(WSP(bf16, WS_QK) + (size_t)tile * 4096 + (w * 64 + lane) * 8) = (v4u){pk2(q[0], q[1]), pk2(q[2], q[3]), pk2(q[4], q[5]), pk2(q[6], q[7])}; }
        __syncthreads();
    }
}

DI void p3c_gates(Frame& F) {
    const int gw = F.vcu * NWAVES + F.wave, NGW = F.G * NWAVES, lane = F.lane;
    const float* GP = WSP(float, WS_GP); float* GS = WSP(float, WS_GS); float* GC = WSP(float, WS_GC);
    for (int gi = gw; gi < NCC * 8; gi += NGW) {
        const int dir = gi & 1, h = (gi >> 1) & 3, cc = gi >> 3;
        const int grow = (cc < 256 ? cc * 64 : M_LAT + (cc - 256) * 64) + lane;
        const float* bias = dir ? F.in[17] : F.in[15];
        float pi = bias[h], pf = bias[4 + h];
#pragma unroll
        for (int hp = 0; hp < 4; ++hp) { pi += GP[((size_t)hp * M_ALL + grow) * 16 + dir * 8 + h]; pf += GP[((size_t)hp * M_ALL + grow) * 16 + dir * 8 + 4 + h]; }
        const float lf = fminf(pf, 0.f) - log1pf(expf(-fabsf(pf)));
        float bc = lf;
        if (dir == 0) {
#pragma unroll
            for (int o = 1; o < 64; o <<= 1) { const float v = __shfl_up(bc, o); if (lane >= o) bc += v; }
        } else {
#pragma unroll
            for (int o = 1; o < 64; o <<= 1) { const float v = __shfl_down(bc, o); if (lane + o < 64) bc += v; }
        }
        const float beta = pi - bc; float cm = beta;
        if (dir == 0) {
#pragma unroll
            for (int o = 1; o < 64; o <<= 1) { const float v = __shfl_up(cm, o); if (lane >= o) cm = fmaxf(cm, v); }
        } else {
#pragma unroll
            for (int o = 1; o < 64; o <<= 1) { const float v = __shfl_down(cm, o); if (lane + o < 64) cm = fmaxf(cm, v); }
        }
        const float mi = bc + cm;
        const float blast = __shfl(bc, dir ? 0 : 63), maxb = __shfl(cm, dir ? 0 : 63);
        const bf16* qkt = WSP(bf16, WS_QK) + (size_t)(cc * 4 + h) * 4096; const int t = lane; float den = 0.f;
#pragma unroll
        for (int ks = 0; ks < 4; ++ks)
#pragma unroll
            for (int hh = 0; hh < 2; ++hh) {
                const v4u q = *(const v4u*)(qkt + ((((t >> 5) * 4 + ks) * 64) + (t & 31) + 32 * hh) * 8);
                const float qv[8] = {bflo(q.x), bfhi(q.x), bflo(q.y), bfhi(q.y), bflo(q.z), bfhi(q.z), bflo(q.w), bfhi(q.w)};
#pragma unroll
                for (int j = 0; j < 8; ++j) { const int s = 16 * ks + 8 * hh + j; const float bs = __shfl(beta, s);
                    const bool ok = dir ? (s >= t) : (s <= t); const float e = __expf(bc + bs - mi); den += ok ? qv[j] * e : 0.f; }
            }
        float* gs = GS + (size_t)gi * 256;
        gs[lane] = bc; gs[64 + lane] = beta; gs[128 + lane] = mi; gs[192 + lane] = den;
        if (lane == 0) { GC[gi * 2] = blast; GC[gi * 2 + 1] = maxb; }
    }
}

DI void scan_phase(Frame& F, const XcdBarrier& bar) {
    const int bid = blockIdx.x, xcd = bid & 7, slot = bid >> 3;
    const int sidx = xcd * 2 + (slot >> 4), es = slot & 15, b = sidx >> 3, h = (sidx >> 1) & 3, dir = sidx & 1;
    const int w = F.wave, lane = F.lane, tid = F.tid, r32 = lane & 31, hh = lane >> 5;
    LAS float* PART = (LAS float*)F.lds;
    LAS float* DP = (LAS float*)(F.lds + 69632);
    LAS float* NV = (LAS float*)(F.lds + 71680);
    LAS unsigned char* Vt = F.lds + 73728; LAS unsigned char* Vu = F.lds + 77824;
    LAS float* TAB = (LAS float*)(F.lds + 81920);
    const bf16* QAg = WSP(bf16, WS_QA); const bf16* KAg = WSP(bf16, WS_KA); const bf16* QKg = WSP(bf16, WS_QK);
    const float* GS = WSP(float, WS_GS); const float* GC = WSP(float, WS_GC); bf16* Hs = WSP(bf16, WS_H);
    const int tV = tid >> 3, pV = tid & 7;
    float wv[16];
    { const float* p = F.in[13] + (size_t)(((h * 512 + 32 * es) >> 2) + pV) * 16;
#pragma unroll
      for (int i = 0; i < 4; ++i) { const f32x4 v = *(const f32x4*)(p + 4 * i); wv[4 * i] = v[0]; wv[4 * i + 1] = v[1]; wv[4 * i + 2] = v[2]; wv[4 * i + 3] = v[3]; } }
    f32x16 Cs0, Cs1;
#pragma unroll
    for (int i = 0; i < 16; ++i) { Cs0[i] = 0.f; Cs1[i] = 0.f; }
    float m_prev = 0.f;
    NV[w * 64 + lane] = 0.f;
#define STEP_ADDR(k_, cc_, xmrow_, lat_) do { if ((k_) < 4) { const int cl_ = dir ? 3 - (k_) : (k_); cc_ = 256 + b * 4 + cl_; lat_ = false; xmrow_ = b * 256 + cl_ * 64; } \
        else { const int kk_ = (k_) - 4; const int cl_ = dir ? 127 - kk_ : kk_; cc_ = b * 128 + cl_; lat_ = true; xmrow_ = b * 8192 + cl_ * 64; } } while (0)
    bf16x8 QAf[2][4], KAf[2][4]; v4u qkf; v2u xmv; float betat, g_b = 0.f, g_beta = 0.f, g_mi = 0.f, g_dn = 0.f, blast, maxb;
#define LOAD_SMALL(k_) do { int cc_, xr_; bool lt_; STEP_ADDR(k_, cc_, xr_, lt_); const int ti_ = cc_ * 4 + h, gi_ = ti_ * 2 + dir; \
        qkf = *(const v4u*)(QKg + (size_t)ti_ * 4096 + (w * 64 + lane) * 8); \
        xmv = *(const v2u*)((lt_ ? (const bf16*)F.out : WSP(bf16, WS_XMC)) + (size_t)(xr_ + tV) * 2048 + h * 512 + 32 * es + 4 * pV); \
        betat = GS[(size_t)gi_ * 256 + 64 + tV]; blast = GC[gi_ * 2]; maxb = GC[gi_ * 2 + 1]; \
        if (w == 0) { g_b = GS[(size_t)gi_ * 256 + lane]; g_beta = GS[(size_t)gi_ * 256 + 64 + lane]; g_mi = GS[(size_t)gi_ * 256 + 128 + lane]; g_dn = GS[(size_t)gi_ * 256 + 192 + lane]; } } while (0)
#define LOAD_QA(k_) do { int cc_, xr_; bool lt_; STEP_ADDR(k_, cc_, xr_, lt_); const bf16* p_ = QAg + (size_t)(cc_ * 4 + h) * 32768 + (size_t)(w * 8) * 512 + lane * 8; \
        _Pragma("unroll") for (int mt_ = 0; mt_ < 2; ++mt_) _Pragma("unroll") for (int ks_ = 0; ks_ < 4; ++ks_) QAf[mt_][ks_] = *(const bf16x8*)(p_ + (mt_ * 4 + ks_) * 512); } while (0)
#define LOAD_KA(k_) do { int cc_, xr_; bool lt_; STEP_ADDR(k_, cc_, xr_, lt_); const bf16* p_ = KAg + (size_t)(cc_ * 4 + h) * 32768 + (size_t)(w * 8) * 512 + lane * 8; \
        _Pragma("unroll") for (int tp_ = 0; tp_ < 2; ++tp_) _Pragma("unroll") for (int j_ = 0; j_ < 4; ++j_) KAf[tp_][j_] = *(const bf16x8*)(p_ + (tp_ * 4 + j_) * 512); } while (0)
    LOAD_SMALL(0); LOAD_QA(0); LOAD_KA(0);
    __syncthreads();
#pragma unroll 1
    for (int k = 0; k < 132; ++k) {
        if (k == 68) xcd_barrier(bar);
        int cc, xmrow; bool lat; STEP_ADDR(k, cc, xmrow, lat);
        LAS float* TB = TAB + (k & 1) * 384;
        const float m_new = fmaxf(blast + m_prev, blast + maxb), decay = __expf(blast + m_prev - m_new);
        if (w == 0) {
            const float mt = fmaxf(g_b + m_prev, g_mi);
            TB[lane] = g_b - mt; TB[64 + lane] = __expf(g_b + m_prev - mt); TB[128 + lane] = g_dn * __expf(g_mi - mt); TB[192 + lane] = __expf(-mt);
            TB[256 + lane] = g_beta; TB[320 + lane] = __expf(blast + g_beta - m_new);
        }
        {   const float x4[4] = {bflo(xmv.x), bfhi(xmv.x), bflo(xmv.y), bfhi(xmv.y)}; const float wg = __expf(blast + betat - m_new);
            const int vo = (tV >> 4) * 1024 + (32 * ((tV >> 3) & 1)) * 16 + (tV & 7) * 2;
#pragma unroll
            for (int o = 0; o < 4; ++o) { const float v = x4[0] * wv[o] + x4[1] * wv[4 + o] + x4[2] * wv[8 + o] + x4[3] * wv[12 + o];
                const int a = vo + (4 * pV + o) * 16;
                *(LAS bf16*)(Vt + a) = (bf16)(pk2(v, 0.f) & 0xffffu); *(LAS bf16*)(Vu + a) = (bf16)(pk2(v * wg, 0.f) & 0xffffu); }
        }
        const v4u qkc = qkf;
        if (k + 1 < 132) LOAD_SMALL(k + 1);
        __syncthreads();
        f32x16 acc0, acc1;
#pragma unroll
        for (int i = 0; i < 16; ++i) { acc0[i] = 0.f; acc1[i] = 0.f; }
        {   bf16x8 cb[4];
#pragma unroll
            for (int s = 0; s < 2; ++s) {
                cb[s] = __builtin_bit_cast(bf16x8, (v4u){pk2(Cs0[8 * s], Cs0[8 * s + 1]), pk2(Cs0[8 * s + 2], Cs0[8 * s + 3]), pk2(Cs0[8 * s + 4], Cs0[8 * s + 5]), pk2(Cs0[8 * s + 6], Cs0[8 * s + 7])});
                cb[2 + s] = __builtin_bit_cast(bf16x8, (v4u){pk2(Cs1[8 * s], Cs1[8 * s + 1]), pk2(Cs1[8 * s + 2], Cs1[8 * s + 3]), pk2(Cs1[8 * s + 4], Cs1[8 * s + 5]), pk2(Cs1[8 * s + 6], Cs1[8 * s + 7])}); }
#pragma unroll
            for (int ks = 0; ks < 4; ++ks) { acc0 = MFMA32(QAf[0][ks], cb[ks], acc0); acc1 = MFMA32(QAf[1][ks], cb[ks], acc1); }
        }
        {   float d0 = 0.f, d1 = 0.f;
#pragma unroll
            for (int ks = 0; ks < 4; ++ks) {
                const f32x4 na = *(const LAS f32x4*)(NV + w * 64 + 16 * ks + 4 * hh), nb = *(const LAS f32x4*)(NV + w * 64 + 16 * ks + 8 + 4 * hh);
                const v4u q0 = __builtin_bit_cast(v4u, QAf[0][ks]), q1 = __builtin_bit_cast(v4u, QAf[1][ks]);
                d0 += bflo(q0.x) * na[0] + bfhi(q0.x) * na[1] + bflo(q0.y) * na[2] + bfhi(q0.y) * na[3] + bflo(q0.z) * nb[0] + bfhi(q0.z) * nb[1] + bflo(q0.w) * nb[2] + bfhi(q0.w) * nb[3];
                d1 += bflo(q1.x) * na[0] + bfhi(q1.x) * na[1] + bflo(q1.y) * na[2] + bfhi(q1.y) * na[3] + bflo(q1.z) * nb[0] + bfhi(q1.z) * nb[1] + bflo(q1.w) * nb[2] + bfhi(q1.w) * nb[3];
            }
            d0 += __shfl_xor(d0, 32); d1 += __shfl_xor(d1, 32);
            if (hh == 0) { DP[r32 * 8 + w] = d0 * TB[64 + r32]; DP[(32 + r32) * 8 + w] = d1 * TB[64 + 32 + r32]; }
        }
        if (k + 1 < 132) LOAD_QA(k + 1);
#pragma unroll
        for (int q = 0; q < 4; ++q) { const f32x4 e0 = *(const LAS f32x4*)(TB + 64 + 8 * q + 4 * hh), e1 = *(const LAS f32x4*)(TB + 64 + 32 + 8 * q + 4 * hh);
#pragma unroll
            for (int i = 0; i < 4; ++i) { acc0[4 * q + i] *= e0[i]; acc1[4 * q + i] *= e1[i]; } }
        {   const int mtw = w >> 2, ksw = w & 3, t = 32 * mtw + r32, s0 = 16 * ksw + 8 * hh;
            const float ta = TB[t]; const f32x4 ba = *(const LAS f32x4*)(TB + 256 + s0), bb = *(const LAS f32x4*)(TB + 256 + s0 + 4);
            const float qv[8] = {bflo(qkc.x), bfhi(qkc.x), bflo(qkc.y), bfhi(qkc.y), bflo(qkc.z), bfhi(qkc.z), bflo(qkc.w), bfhi(qkc.w)};
            const float be[8] = {ba[0], ba[1], ba[2], ba[3], bb[0], bb[1], bb[2], bb[3]};
            float sv[8];
#pragma unroll
            for (int j = 0; j < 8; ++j) { const int s = s0 + j; const bool ok = dir ? (s >= t) : (s <= t); const float e = __expf(ta + be[j]); sv[j] = ok ? qv[j] * e : 0.f; }
            const bf16x8 sf = __builtin_bit_cast(bf16x8, (v4u){pk2(sv[0], sv[1]), pk2(sv[2], sv[3]), pk2(sv[4], sv[5]), pk2(sv[6], sv[7])});
            const bf16x8 vf = *(const LAS bf16x8*)(Vt + ksw * 1024 + lane * 16);
            if (mtw == 0) acc0 = MFMA32(sf, vf, acc0); else acc1 = MFMA32(sf, vf, acc1);
        }
#pragma unroll
        for (int q = 0; q < 4; ++q) {
            *(LAS f32x4*)(PART + (w * 32 + r32) * 68 + 8 * q + 4 * hh) = (f32x4){acc0[4 * q], acc0[4 * q + 1], acc0[4 * q + 2], acc0[4 * q + 3]};
            *(LAS f32x4*)(PART + (w * 32 + r32) * 68 + 32 + 8 * q + 4 * hh) = (f32x4){acc1[4 * q], acc1[4 * q + 1], acc1[4 * q + 2], acc1[4 * q + 3]}; }
#pragma unroll
        for (int i = 0; i < 16; ++i) { Cs0[i] *= decay; Cs1[i] *= decay; }
#pragma unroll
        for (int j = 0; j < 4; ++j) { const bf16x8 vf = *(const LAS bf16x8*)(Vu + j * 1024 + lane * 16); Cs0 = MFMA32(KAf[0][j], vf, Cs0); Cs1 = MFMA32(KAf[1][j], vf, Cs1); }
        {   float p0 = 0.f, p1 = 0.f;
#pragma unroll
            for (int j = 0; j < 4; ++j) {
                const f32x4 wa = *(const LAS f32x4*)(TB + 320 + 16 * j + 8 * hh), wb = *(const LAS f32x4*)(TB + 320 + 16 * j + 8 * hh + 4);
                const v4u k0 = __builtin_bit_cast(v4u, KAf[0][j]), k1 = __builtin_bit_cast(v4u, KAf[1][j]);
                p0 += bflo(k0.x) * wa[0] + bfhi(k0.x) * wa[1] + bflo(k0.y) * wa[2] + bfhi(k0.y) * wa[3] + bflo(k0.z) * wb[0] + bfhi(k0.z) * wb[1] + bflo(k0.w) * wb[2] + bfhi(k0.w) * wb[3];
                p1 += bflo(k1.x) * wa[0] + bfhi(k1.x) * wa[1] + bflo(k1.y) * wa[2] + bfhi(k1.y) * wa[3] + bflo(k1.z) * wb[0] + bfhi(k1.z) * wb[1] + bflo(k1.w) * wb[2] + bfhi(k1.w) * wb[3];
            }
            p0 += __shfl_xor(p0, 32); p1 += __shfl_xor(p1, 32);
            if (hh == 0) { NV[w * 64 + r32] = decay * NV[w * 64 + r32] + p0; NV[w * 64 + 32 + r32] = decay * NV[w * 64 + 32 + r32] + p1; }
        }
        if (k + 1 < 132) LOAD_KA(k + 1);
        __syncthreads();
        if (lat) {
            const int e = tid & 31, tq = tid >> 5; f32x4 num = {0.f, 0.f, 0.f, 0.f};
#pragma unroll
            for (int ww = 0; ww < 8; ++ww) num += *(const LAS f32x4*)(PART + (ww * 32 + e) * 68 + 4 * tq);
            bf16* hp = Hs + (size_t)(xmrow + 4 * tq) * 2048 + h * 512 + 32 * es + e; const bool second = (k >= 68);
#pragma unroll
            for (int i = 0; i < 4; ++i) { const int t = 4 * tq + i; const f32x4 da = *(const LAS f32x4*)(DP + t * 8), db = *(const LAS f32x4*)(DP + t * 8 + 4);
                const float den = TB[128 + t] + ((da[0] + da[1]) + (da[2] + da[3])) + ((db[0] + db[1]) + (db[2] + db[3]));
                float hv = num[i] / fmaxf(fabsf(den), TB[192 + t]);
                if (second) hv += __uint_as_float((unsigned)hp[(size_t)i * 2048] << 16);
                hp[(size_t)i * 2048] = (bf16)(pk2(hv, 0.f) & 0xffffu); }
        }
        m_prev = m_new;
    }
#undef STEP_ADDR
#undef LOAD_SMALL
#undef LOAD_QA
#undef LOAD_KA
}

DI void p9a_cols(Frame& F) {
    const bf16* U = WSP(bf16, WS_U); bf16* M1 = WSP(bf16, WS_M1);
    for (int task = F.vcu * NTHR + F.tid; task < 2 * 128 * 2 * 256; task += F.G * NTHR) {
        const int fc = task & 255, half = (task >> 8) & 1, r = (task >> 9) & 127, bb = task >> 16;
        const int g = fc >> 6, wdw = 2 << g, lo_off = wdw >> 1, hi_off = wdw - lo_off;
        const bf16* up = U + ((size_t)(bb * 8192 + r * 64)) * 2048 + fc * 8; bf16* mp = M1 + ((size_t)(bb * 8192 + r * 64)) * 2048 + fc * 8;
        const int cs = half * 32; float S[8] = {0.f, 0.f, 0.f, 0.f, 0.f, 0.f, 0.f, 0.f};
        { const int lo = cs - lo_off < 0 ? 0 : cs - lo_off, hi = cs + hi_off > 64 ? 64 : cs + hi_off;
          for (int c = lo; c < hi; ++c) { const v4u v = *(const v4u*)(up + (size_t)c * 2048);
              S[0] += bflo(v.x); S[1] += bfhi(v.x); S[2] += bflo(v.y); S[3] += bfhi(v.y); S[4] += bflo(v.z); S[5] += bfhi(v.z); S[6] += bflo(v.w); S[7] += bfhi(v.w); } }
        for (int c = cs; c < cs + 32; ++c) {
            const int lo = c - lo_off < 0 ? 0 : c - lo_off, hi = c + hi_off > 64 ? 64 : c + hi_off; const float inv = 1.f / (float)(hi - lo);
            *(v4u*)(mp + (size_t)c * 2048) = (v4u){pk2(S[0] * inv, S[1] * inv), pk2(S[2] * inv, S[3] * inv), pk2(S[4] * inv, S[5] * inv), pk2(S[6] * inv, S[7] * inv)};
            if (c + hi_off < 64) { const v4u v = *(const v4u*)(up + (size_t)(c + hi_off) * 2048);
                S[0] += bflo(v.x); S[1] += bfhi(v.x); S[2] += bflo(v.y); S[3] += bfhi(v.y); S[4] += bflo(v.z); S[5] += bfhi(v.z); S[6] += bflo(v.w); S[7] += bfhi(v.w); }
            if (c - lo_off >= 0) { const v4u v = *(const v4u*)(up + (size_t)(c - lo_off) * 2048);
                S[0] -= bflo(v.x); S[1] -= bfhi(v.x); S[2] -= bflo(v.y); S[3] -= bfhi(v.y); S[4] -= bflo(v.z); S[5] -= bfhi(v.z); S[6] -= bflo(v.w); S[7] -= bfhi(v.w); }
        }
    }
}
DI void p9b_rows(Frame& F) {
    bf16* U = WSP(bf16, WS_U); const bf16* M1 = WSP(bf16, WS_M1);
    for (int task = F.vcu * NTHR + F.tid; task < 2 * 64 * 4 * 256; task += F.G * NTHR) {
        const int fc = task & 255, qr = (task >> 8) & 3, c = (task >> 10) & 63, bb = task >> 16;
        const int g = fc >> 6, wdw = 2 << g, lo_off = wdw >> 1, hi_off = wdw - lo_off;
        const bf16* mp = M1 + ((size_t)(bb * 8192 + c)) * 2048 + fc * 8; bf16* up = U + ((size_t)(bb * 8192 + c)) * 2048 + fc * 8;
        const int rs = qr * 32; float S[8] = {0.f, 0.f, 0.f, 0.f, 0.f, 0.f, 0.f, 0.f};
        { const int lo = rs - lo_off < 0 ? 0 : rs - lo_off, hi = rs + hi_off > 128 ? 128 : rs + hi_off;
          for (int r = lo; r < hi; ++r) { const v4u v = *(const v4u*)(mp + (size_t)r * 64 * 2048);
              S[0] += bflo(v.x); S[1] += bfhi(v.x); S[2] += bflo(v.y); S[3] += bfhi(v.y); S[4] += bflo(v.z); S[5] += bfhi(v.z); S[6] += bflo(v.w); S[7] += bfhi(v.w); } }
        for (int r = rs; r < rs + 32; ++r) {
            const int lo = r - lo_off < 0 ? 0 : r - lo_off, hi = r + hi_off > 128 ? 128 : r + hi_off; const float inv = 1.f / (float)(hi - lo);
            const v4u uv = *(const v4u*)(up + (size_t)r * 64 * 2048);
            *(v4u*)(up + (size_t)r * 64 * 2048) = (v4u){pk2(S[0] * inv - bflo(uv.x), S[1] * inv - bfhi(uv.x)), pk2(S[2] * inv - bflo(uv.y), S[3] * inv - bfhi(uv.y)),
                                                      pk2(S[4] * inv - bflo(uv.z), S[5] * inv - bfhi(uv.z)), pk2(S[6] * inv - bflo(uv.w), S[7] * inv - bfhi(uv.w))};
            if (r + hi_off < 128) { const v4u v = *(const v4u*)(mp + (size_t)(r + hi_off) * 64 * 2048);
                S[0] += bflo(v.x); S[1] += bfhi(v.x); S[2] += bflo(v.y); S[3] += bfhi(v.y); S[4] += bflo(v.z); S[5] += bfhi(v.z); S[6] += bflo(v.w); S[7] += bfhi(v.w); }
            if (r - lo_off >= 0) { const v4u v = *(const v4u*)(mp + (size_t)(r - lo_off) * 64 * 2048);
                S[0] -= bflo(v.x); S[1] -= bfhi(v.x); S[2] -= bflo(v.y); S[3] -= bfhi(v.y); S[4] -= bflo(v.z); S[5] -= bfhi(v.z); S[6] -= bflo(v.w); S[7] -= bfhi(v.w); }
        }
    }
}
#ifndef PROBE_PH
#define PROBE_PH -1
#endif
#ifndef PROBE_SYNCS
#define PROBE_SYNCS 0
#endif
template <int K> DI void run_phase(Frame& F, const XcdBarrier& bar) {
    typedef pg8::bf16_t pbf;
    if constexpr (K == 0) { p0_prologue(F); }
    else if constexpr (K == 1) { p1_hn(F, WSP(bf16, WS_HN), M_ALL); }
    else if constexpr (K == 2) {
        pg8::Gemm g{WSP(pbf, WS_HN), WSP(pbf, WS_WXM), M_ALL, 2048, 1024, 1024, 1024, -1}; pg8::StaticOrder S; S.init(M_ALL, 2048, F.G, (int)blockIdx.x);
        pg8::EpiXM Ep{(pbf*)F.out, WSP(pbf, WS_XMC)};
        pg8::gemm_phase<pg8::EpiXM, pg8::StaticOrder, true, true>(F.lds, g, S, Ep);
    }
    else if constexpr (K == 3) { p3_conv(F); }
    else if constexpr (K == 4) { p3c_gates(F); }
    else if constexpr (K == 5) { scan_phase(F, bar); }
    else if constexpr (K == 6) { p5b_stats(F); }
    else if constexpr (K == 7) {
        pg8::Gemm g{WSP(pbf, WS_HN2), WSP(pbf, WS_WZO), M_LAT, 4096, 1024, 1024, 1024, -1}; pg8::StaticOrder S; S.init(M_LAT, 4096, F.G, (int)blockIdx.x);
        pg8::EpiMix Ep{WSP(pbf, WS_Y), WSP(pbf, WS_H), (const pbf*)F.out, WSP(float, WS_ST), F.in[9], F.in[10], F.in[18], F.in[19]};
        pg8::gemm_phase<pg8::EpiMix, pg8::StaticOrder, true, true>(F.lds, g, S, Ep);
    }
    else if constexpr (K == 8) {
        pg8::Gemm g{WSP(pbf, WS_Y), WSP(pbf, WS_WOA), M_LAT, 1024, 2048, 2048, 2048, -1}; pg8::StaticOrder S; S.init(M_LAT, 1024, F.G, (int)blockIdx.x);
        pg8::EpiF32 Ep{WSP(float, WS_YL), 1024};
        pg8::gemm_phase<pg8::EpiF32, pg8::StaticOrder, true, true>(F.lds, g, S, Ep);
    }
    else if constexpr (K == 9) { p7b_rows(F); }
    else if constexpr (K == 10) {
        pg8::Gemm g{WSP(pbf, WS_HN1), WSP(pbf, WS_WBIN), M_LAT, 4096, 1024, 1024, 1024, -1}; pg8::StaticOrder S; S.init(M_LAT, 4096, F.G, (int)blockIdx.x);
        pg8::EpiUZ Ep{WSP(pbf, WS_U), WSP(pbf, WS_Z1)};
        pg8::gemm_phase<pg8::EpiUZ, pg8::StaticOrder, true, true>(F.lds, g, S, Ep);
    }
    else if constexpr (K == 11) { p9a_cols(F); }
    else if constexpr (K == 12) { p9b_rows(F); }
    else if constexpr (K == 13) {
        pg8::Gemm g{WSP(pbf, WS_U), WSP(pbf, WS_WPOOL), M_LAT, 2048, 512, 2048, 512, 1}; pg8::StaticOrder S; S.init(M_LAT, 2048, F.G, (int)blockIdx.x);
        pg8::EpiPool Ep{WSP(pbf, WS_Y1), WSP(pbf, WS_Z1), F.in[25]};
        pg8::gemm_phase<pg8::EpiPool, pg8::StaticOrder, true, true>(F.lds, g, S, Ep);
    }
    else if constexpr (K == 14) {
        pg8::Gemm g{WSP(pbf, WS_Y1), WSP(pbf, WS_WBOUT), M_LAT, 1024, 2048, 2048, 2048, -1}; pg8::StaticOrder S; S.init(M_LAT, 1024, F.G, (int)blockIdx.x);
        pg8::EpiF32 Ep{WSP(float, WS_YL1), 1024};
        pg8::gemm_phase<pg8::EpiF32, pg8::StaticOrder, true, true>(F.lds, g, S, Ep);
    }
    else if constexpr (K == 15) { p11b_rows(F); }
}
__global__ void __launch_bounds__(NTHR, 2) mk_fwd(Args args) {
    extern __shared__ __attribute__((aligned(16))) unsigned char lds_raw[];
    cg::grid_group grid = cg::this_grid();
    Frame F;
    F.lds = (LAS unsigned char*)lds_raw;
    F.tid = threadIdx.x; F.lane = F.tid & 63; F.wave = __builtin_amdgcn_readfirstlane(F.tid >> 6);
    F.G = gridDim.x; { const int bx = blockIdx.x; F.vcu = (F.G % 8 == 0) ? (bx % 8) * (F.G / 8) + bx / 8 : bx; }
    F.in = args.in; F.out = args.out; F.ws = args.ws;
    const int lo = args.ph_lo, hi = args.ph_hi;
    if (F.tid < 64) ((LAS unsigned*)(F.lds + 131072))[F.tid] = 0u;
    unsigned* barw = (unsigned*)(F.ws);
    if (blockIdx.x == 0) for (int i = F.tid; i < XCD_BAR_WORDS; i += NTHR) __hip_atomic_store(barw + i, 0u, __ATOMIC_RELAXED, __HIP_MEMORY_SCOPE_AGENT);
    __syncthreads();
    grid.sync();
    const XcdBarrier bar = xcd_barrier_post(barw, (volatile LAS unsigned*)(F.lds + 131072) + 8);
#define IN(k) (lo <= (k) && (k) < hi)
#define PHASE(k) do { if (IN(k)) run_phase<k>(F, bar); if (PROBE_PH == (k)) { xcd_barrier(bar); run_phase<k>(F, bar); } \
        if ((k) == 14) { for (int i_ = 0; i_ < PROBE_SYNCS; ++i_) xcd_barrier(bar); } if ((k) < 15 && IN(k) && IN((k) + 1)) xcd_barrier(bar); } while (0)
    PHASE(0); PHASE(1); PHASE(2); PHASE(3); PHASE(4); PHASE(5); PHASE(6); PHASE(7); PHASE(8); PHASE(9); PHASE(10); PHASE(11); PHASE(12); PHASE(13); PHASE(14); PHASE(15);
#undef IN
#undef PHASE
}

extern "C" void kernel_launch(void* const* d_in, const int* in_sizes, int n_in, void* d_out, int out_size, void* d_ws, size_t ws_size, hipStream_t stream) {
    static int grid = 0;
    if (grid == 0) {
        if (n_in != 27 || out_size != M_LAT * DM || ws_size < WS_END) { fprintf(stderr, "kernel_launch: unexpected problem (n_in %d, out %d, ws %zu); nothing launched\n", n_in, out_size, ws_size); grid = -1; return; }
        int dev = 0, cus = 0, per_cu = 0;
        if (hipGetDevice(&dev) != hipSuccess || hipDeviceGetAttribute(&cus, hipDeviceAttributeMultiprocessorCount, dev) != hipSuccess) { grid = -1; return; }
        if (hipFuncSetAttribute((const void*)mk_fwd, hipFuncAttributeMaxDynamicSharedMemorySize, LDS_BYTES) != hipSuccess) { fprintf(stderr, "kernel_launch: hipFuncSetAttribute failed\n"); grid = -1; return; }
        if (hipOccupancyMaxActiveBlocksPerMultiprocessor(&per_cu, (const void*)mk_fwd, NTHR, LDS_BYTES) != hipSuccess || per_cu < 1) { fprintf(stderr, "kernel_launch: occupancy query reports %d blocks per CU\n", per_cu); grid = -1; return; }
        if (cus != 256) { fprintf(stderr, "kernel_launch: built for 256 CUs, found %d\n", cus); grid = -1; return; }
        grid = cus;
    }
    if (grid < 0) return;
    Args a{};
    for (int i = 0; i < 27; ++i) a.in[i] = (const float*)d_in[i];
    a.out = (float*)d_out; a.ws = (unsigned char*)d_ws;
    void* kargs[] = {&a};
#if MK_N_LAUNCHES == 1
    a.ph_lo = 0; a.ph_hi = NPH;
    hipError_t e = hipLaunchCooperativeKernel((void*)mk_fwd, dim3(grid), dim3(NTHR), kargs, LDS_BYTES, stream);
    if (e != hipSuccess) fprintf(stderr, "kernel_launch: cooperative launch failed: %s\n", hipGetErrorString(e));
#else
    for (int p = 0; p < NPH; ++p) { a.ph_lo = p; a.ph_hi = p + 1;
        hipError_t e = hipLaunchCooperativeKernel((void*)mk_fwd, dim3(grid), dim3(NTHR), kargs, LDS_BYTES, stream);
        if (e != hipSuccess) { fprintf(stderr, "kernel_launch: launch %d failed: %s\n", p, hipGetErrorString(e)); break; } }
#endif
}
```
